# Optimizing an MI355X kernel written in HIP

```python
import math
import jax, jax.numpy as jnp
from jax import lax
import numpy as np

D_MODEL = 1024
BATCH = 8
SEQ = 8192
DEPTH = 2

HEAD_DIM = 64
NSA_HEADS = 8
NSA_KV_HEADS = 2
NSA_GROUP = NSA_HEADS // NSA_KV_HEADS
RET_HEADS = 8
CMP_BLOCK = 32
CMP_STRIDE = 16
CMP_HIDDEN = 256
SEL_BLOCK = 64
N_SELECT = 16
N_LOCAL_SEL = 2
WINDOW = 512
Q_BLOCK = 128
RET_CHUNK = 128
D_FF = 3584
N_EXPERTS = 8
TOP_K = 2
PLE_DIM = 256
EPS = 1e-6
NEG_INF = -1e30
BIG = 1e9
N_DENSE = (DEPTH + 1) // 2
N_MOE = DEPTH // 2

NSA_Q_COLS = NSA_HEADS * HEAD_DIM
NSA_KV_COLS = NSA_KV_HEADS * HEAD_DIM
NSA_GATE_COLS = 3 * NSA_HEADS
RET_COLS = RET_HEADS * HEAD_DIM
SPLIT_SIZES = (NSA_Q_COLS,) + (NSA_KV_COLS,) * 6 + (NSA_GATE_COLS,) + (RET_COLS,) * 4
IN_COLS = NSA_Q_COLS + 6 * NSA_KV_COLS + NSA_GATE_COLS + 4 * RET_COLS
MIX_WIDTH = NSA_Q_COLS + RET_COLS

kernel_name = "hybrid_nsa_retention_moe_ple"


def rmsnorm(x, g):
    xf = x.astype(jnp.float32)
    y = xf * lax.rsqrt(jnp.mean(xf * xf, axis=-1, keepdims=True) + EPS)
    return (y * g.astype(jnp.float32)).astype(x.dtype)


def alibi_slopes(n):
    return jnp.exp2(-8.0 * jnp.arange(1, n + 1, dtype=jnp.float32) / n)


def masked_softmax(logits, valid):
    l = jnp.where(valid, logits, NEG_INF)
    m = jnp.max(l, axis=-1, keepdims=True)
    e = jnp.where(valid, jnp.exp(l - m), 0.0)
    return e / jnp.maximum(jnp.sum(e, axis=-1, keepdims=True), 1e-30)


def compress(k, pos, w1, w2):
    b, g, s, d = k.shape
    r = CMP_BLOCK // CMP_STRIDE
    nch = s // CMP_STRIDE
    nc = nch - r + 1
    chunks = k.reshape(b, g, nch, CMP_STRIDE, d)
    w1r = w1.reshape(r, CMP_STRIDE, d, CMP_HIDDEN)
    u = jnp.einsum('bgncd,rcdh->bgnrh', chunks, w1r)
    hid = jnp.einsum('ld,ldh->h', pos, w1)
    for a in range(r):
        hid = hid + u[:, :, a:a + nc, a, :]
    return jnp.einsum('bgnh,hd->bgnd', jax.nn.gelu(hid), w2)


def nsa_mixer(q, kc, vc, ks, vs, kw, vw, gate_logits, cmp_pos, cmp_w1, cmp_w2):
    f32 = jnp.float32
    b, s, _, d = q.shape
    G, R = NSA_KV_HEADS, NSA_GROUP
    q = q.astype(f32) * (d ** -0.5)
    to_bgsd = lambda t: jnp.transpose(t.astype(f32), (0, 2, 1, 3))
    kc, vc, ks, vs, kw, vw = [to_bgsd(t) for t in (kc, vc, ks, vs, kw, vw)]
    k_cmp = compress(kc, cmp_pos[0].astype(f32), cmp_w1[0].astype(f32), cmp_w2[0].astype(f32))
    v_cmp = compress(vc, cmp_pos[1].astype(f32), cmp_w1[1].astype(f32), cmp_w2[1].astype(f32))
    nc = k_cmp.shape[2]
    nsel = s // SEL_BLOCK
    n_pick = min(N_SELECT, nsel)
    cmp_start = jnp.arange(nc) * CMP_STRIDE
    cmp_end = cmp_start + CMP_BLOCK - 1
    sel_start = jnp.arange(nsel) * SEL_BLOCK
    overlap = (jnp.minimum(cmp_start[:, None] + CMP_BLOCK, sel_start[None, :] + SEL_BLOCK)
               > jnp.maximum(cmp_start[:, None], sel_start[None, :])).astype(f32)
    ks_blk = ks.reshape(b, G, nsel, SEL_BLOCK, d)
    vs_blk = vs.reshape(b, G, nsel, SEL_BLOCK, d)
    kw_pad = jnp.pad(kw, ((0, 0), (0, 0), (WINDOW, 0), (0, 0)))
    vw_pad = jnp.pad(vw, ((0, 0), (0, 0), (WINDOW, 0), (0, 0)))
    slopes = alibi_slopes(NSA_HEADS).reshape(G, R)
    gates = jax.nn.sigmoid(gate_logits.astype(f32)).reshape(b, s, 3, G, R)
    gather = jax.vmap(jax.vmap(lambda blocks, ix: blocks[ix]))
    blk = jnp.arange(nsel)

    def block(i):
        t0 = i * Q_BLOCK
        t = t0 + jnp.arange(Q_BLOCK)
        qb = lax.dynamic_slice_in_dim(q, t0, Q_BLOCK, axis=1).reshape(b, Q_BLOCK, G, R, d)
        dist_c = t[:, None] - cmp_end[None, :]
        s_c = jnp.einsum('bqgrd,bgnd->bgrqn', qb, k_cmp)
        p_c = masked_softmax(s_c - slopes[:, :, None, None] * dist_c.astype(f32), dist_c >= 0)
        o_c = jnp.einsum('bgrqn,bgnd->bgrqd', p_c, v_cmp)
        imp = jnp.einsum('bgrqn,nm->bgqm', p_c, overlap)
        back = (t // SEL_BLOCK)[:, None] - blk[None, :]
        forced = (blk[None, :] == 0) | ((back >= 0) & (back < N_LOCAL_SEL))
        score = jnp.where(forced, BIG, jnp.where(back >= 0, imp, -BIG))
        _, idx = lax.top_k(score, n_pick)
        k_pick = gather(ks_blk, idx)
        v_pick = gather(vs_blk, idx)
        pos = idx[..., None] * SEL_BLOCK + jnp.arange(SEL_BLOCK)
        dist_s = t[None, None, :, None, None] - pos
        s_s = jnp.einsum('bqgrd,bgqkld->bgrqkl', qb, k_pick)
        logit_s = (s_s - slopes[None, :, :, None, None, None] * dist_s[:, :, None].astype(f32))
        logit_s = logit_s.reshape(b, G, R, Q_BLOCK, n_pick * SEL_BLOCK)
        valid_s = (dist_s >= 0)[:, :, None].reshape(b, G, 1, Q_BLOCK, n_pick * SEL_BLOCK)
        p_s = masked_softmax(logit_s, valid_s).reshape(b, G, R, Q_BLOCK, n_pick, SEL_BLOCK)
        o_s = jnp.einsum('bgrqkl,bgqkld->bgrqd', p_s, v_pick)
        kwb = lax.dynamic_slice_in_dim(kw_pad, t0, WINDOW + Q_BLOCK, axis=2)
        vwb = lax.dynamic_slice_in_dim(vw_pad, t0, WINDOW + Q_BLOCK, axis=2)
        kpos = t0 - WINDOW + jnp.arange(WINDOW + Q_BLOCK)
        dist_w = t[:, None] - kpos[None, :]
        valid_w = (dist_w >= 0) & (dist_w < WINDOW) & (kpos[None, :] >= 0)
        s_w = jnp.einsum('bqgrd,bgkd->bgrqk', qb, kwb)
        p_w = masked_softmax(s_w - slopes[:, :, None, None] * dist_w.astype(f32), valid_w)
        o_w = jnp.einsum('bgrqk,bgkd->bgrqd', p_w, vwb)
        gb = lax.dynamic_slice_in_dim(gates, t0, Q_BLOCK, axis=1)
        gb = jnp.transpose(gb, (2, 0, 3, 4, 1))[..., None]
        o = gb[0] * o_c + gb[1] * o_s + gb[2] * o_w
        return jnp.transpose(o, (0, 3, 1, 2, 4)).reshape(b, Q_BLOCK, NSA_HEADS * d)

    out = lax.map(block, jnp.arange(s // Q_BLOCK))
    return jnp.transpose(out, (1, 0, 2, 3)).reshape(b, s, NSA_HEADS * d)


def retention(q, k, v, g, gn_gain):
    f32 = jnp.float32
    b, s, h, d = q.shape
    C = RET_CHUNK
    n = s // C
    log_gamma = jnp.log1p(-jnp.exp2(-5.0 - jnp.arange(h, dtype=f32)))
    pos = jnp.arange(C, dtype=f32)
    diff = pos[:, None] - pos[None, :]
    decay_in = jnp.where(diff >= 0, jnp.exp(jnp.maximum(diff, 0.0)[None] * log_gamma[:, None, None]), 0.0)
    xi = jnp.exp((pos + 1.0)[None] * log_gamma[:, None])[..., None]
    zeta = jnp.exp((C - 1.0 - pos)[None] * log_gamma[:, None])[..., None]
    g_chunk = jnp.exp(C * log_gamma)[:, None, None]

    def chunks(t):
        return jnp.transpose(t.astype(f32).reshape(b, n, C, h, d), (1, 0, 3, 2, 4))

    qc, kc, vc = chunks(q), chunks(k) * (d ** -0.5), chunks(v)

    def step(state, inp):
        qi, ki, vi = inp
        inner = jnp.einsum('bhnd,bhmd->bhnm', qi, ki) * decay_in
        o = (jnp.einsum('bhnm,bhme->bhne', inner, vi)
             + jnp.einsum('bhnd,bhde->bhne', qi, state) * xi)
        state = g_chunk * state + jnp.einsum('bhmd,bhme->bhde', ki * zeta, vi)
        return state, o

    state0 = jnp.zeros((b, h, d, d), f32)
    _, o = lax.scan(step, state0, (qc, kc, vc))
    o = jnp.transpose(o, (1, 0, 3, 2, 4)).reshape(b, s, h, d)
    mu = jnp.mean(o, axis=-1, keepdims=True)
    var = jnp.mean(jnp.square(o - mu), axis=-1, keepdims=True)
    o = ((o - mu) * lax.rsqrt(var + EPS)).reshape(b, s, h * d) * gn_gain.astype(f32)
    return (jax.nn.silu(g.astype(f32)).reshape(b, s, h * d) * o).astype(q.dtype)


def swiglu(x, wg, wu, wd):
    return (jax.nn.silu(x @ wg) * (x @ wu)) @ wd


def moe(x, router, wg, wu, wd):
    b, s, dm = x.shape
    xt = x.reshape(-1, dm)
    logits = (xt @ router).astype(jnp.float32)
    top_v, top_i = lax.top_k(logits, TOP_K)
    w = jax.nn.softmax(top_v, axis=-1)
    gate = jnp.sum(jax.nn.one_hot(top_i, N_EXPERTS, dtype=jnp.float32) * w[..., None], axis=1)
    out = jnp.zeros(xt.shape, jnp.float32)
    for e in range(N_EXPERTS):
        out = out + gate[:, e:e + 1] * swiglu(xt, wg[e], wu[e], wd[e]).astype(jnp.float32)
    return out.astype(x.dtype).reshape(b, s, dm)


def setup_inputs(seed: int = 0) -> dict:
    key = jax.random.key(seed)
    k = jax.random.split(key, 21)
    nrm = lambda kk, shape, scale: jax.random.normal(kk, shape, jnp.float32) * scale
    gain = lambda kk, shape: 1.0 + 0.01 * jax.random.normal(kk, shape, jnp.float32)
    return {
        "x": nrm(k[0], (BATCH, SEQ, D_MODEL), 1.0),
        "p": nrm(k[1], (DEPTH, BATCH, SEQ, PLE_DIM), 1.0),
        "w_in": nrm(k[2], (DEPTH, D_MODEL, IN_COLS), D_MODEL ** -0.5),
        "w_out": nrm(k[3], (DEPTH, MIX_WIDTH, D_MODEL), MIX_WIDTH ** -0.5),
        "g_mix": gain(k[4], (DEPTH, D_MODEL)),
        "g_ffn": gain(k[5], (DEPTH, D_MODEL)),
        "g_ple": gain(k[6], (DEPTH, D_MODEL)),
        "g_final": gain(k[7], (D_MODEL,)),
        "cmp_pos": nrm(k[8], (DEPTH, 2, CMP_BLOCK, HEAD_DIM), 0.1),
        "cmp_w1": nrm(k[9], (DEPTH, 2, CMP_BLOCK, HEAD_DIM, CMP_HIDDEN), (CMP_BLOCK * HEAD_DIM) ** -0.5),
        "cmp_w2": nrm(k[10], (DEPTH, 2, CMP_HIDDEN, HEAD_DIM), CMP_HIDDEN ** -0.5),
        "ret_gn": gain(k[11], (DEPTH, RET_COLS)),
        "ffn_gate": nrm(k[12], (N_DENSE, D_MODEL, D_FF), D_MODEL ** -0.5),
        "ffn_up": nrm(k[13], (N_DENSE, D_MODEL, D_FF), D_MODEL ** -0.5),
        "ffn_down": nrm(k[14], (N_DENSE, D_FF, D_MODEL), D_FF ** -0.5),
        "moe_router": nrm(k[15], (N_MOE, D_MODEL, N_EXPERTS), D_MODEL ** -0.5),
        "moe_gate": nrm(k[16], (N_MOE, N_EXPERTS, D_MODEL, D_FF), D_MODEL ** -0.5),
        "moe_up": nrm(k[17], (N_MOE, N_EXPERTS, D_MODEL, D_FF), D_MODEL ** -0.5),
        "moe_down": nrm(k[18], (N_MOE, N_EXPERTS, D_FF, D_MODEL), D_FF ** -0.5),
        "ple_proj": nrm(k[19], (DEPTH, PLE_DIM, D_MODEL), PLE_DIM ** -0.5),
        "ple_gate": nrm(k[20], (DEPTH, D_MODEL, D_MODEL), D_MODEL ** -0.5),
    }


def reference(x, p, w_in, w_out, g_mix, g_ffn, g_ple, g_final, cmp_pos, cmp_w1, cmp_w2, ret_gn,
              ffn_gate, ffn_up, ffn_down, moe_router, moe_gate, moe_up, moe_down, ple_proj, ple_gate):
    b, s, _ = x.shape
    split_points = np.cumsum(SPLIT_SIZES)[:-1].tolist()
    h = x
    for i in range(DEPTH):
        hn = rmsnorm(h, g_mix[i])
        z = hn @ w_in[i]
        (q_n, kc, vc, ks, vs, kw, vw, gl, q_r, k_r, v_r, g_r) = jnp.split(z, split_points, axis=-1)
        kvr = lambda t: t.reshape(b, s, NSA_KV_HEADS, HEAD_DIM)
        rr = lambda t: t.reshape(b, s, RET_HEADS, HEAD_DIM)
        a = nsa_mixer(q_n.reshape(b, s, NSA_HEADS, HEAD_DIM), kvr(kc), kvr(vc), kvr(ks), kvr(vs),
                      kvr(kw), kvr(vw), gl, cmp_pos[i], cmp_w1[i], cmp_w2[i]).astype(h.dtype)
        r = retention(rr(q_r), rr(k_r), rr(v_r), rr(g_r), ret_gn[i])
        h = h + jnp.concatenate([a, r], axis=-1) @ w_out[i]
        hn = rmsnorm(h, g_ffn[i])
        if i % 2 == 0:
            f = swiglu(hn, ffn_gate[i // 2], ffn_up[i // 2], ffn_down[i // 2])
        else:
            f = moe(hn, moe_router[i // 2], moe_gate[i // 2], moe_up[i // 2], moe_down[i // 2])
        h = h + f
        h = h + (p[i] @ ple_proj[i]) * jax.nn.sigmoid(rmsnorm(h, g_ple[i]) @ ple_gate[i])
    return rmsnorm(h, g_final)
```

```cpp
#include <hip/hip_runtime.h>
#include <cstdio>
#include <cstdint>

#define DI __device__ __forceinline__
#define LAS __attribute__((address_space(3)))
#define GAS __attribute__((address_space(1)))
typedef unsigned short bf16;
typedef short bf16x8 __attribute__((ext_vector_type(8)));
typedef float f32x4 __attribute__((ext_vector_type(4)));
typedef float f32x2 __attribute__((ext_vector_type(2)));
typedef unsigned u32x4 __attribute__((ext_vector_type(4)));
typedef unsigned u32x2 __attribute__((ext_vector_type(2)));
typedef __bf16 bf16x2_t __attribute__((ext_vector_type(2)));

constexpr int NB = 8, SEQ = 8192, T = NB * SEQ, D = 1024, DFF = 3584, NE = 8, PLE = 256;
constexpr int IN_COLS = 3352, ZP = 3584;
constexpr int Z_QN = 0, Z_KC = 512, Z_VC = 640, Z_KS = 768, Z_VS = 896, Z_KW = 1024, Z_VW = 1152, Z_QR = 1280, Z_KR = 1792, Z_VR = 2304, Z_GR = 2816, Z_GL = 3328;
constexpr float EPS = 1e-6f, LOG2E = 1.4426950408889634f;
constexpr int MAXROWS = 2 * T + NE * 256;
constexpr int MOE_ROUNDS = 3, RPANELS_MAX = 174;

constexpr size_t MiB = 1u << 20;
constexpr size_t WS_CTL = 0, CTL_ZERO_BYTES = 1 * MiB;
constexpr size_t WS_POSB = 1 * MiB;
constexpr size_t WS_BCNT = 1 * MiB + 65536;
constexpr size_t WS_META = 1 * MiB + 131072;
constexpr size_t WS_TOKINFO = 2 * MiB;
constexpr size_t WS_TOKROW = 3 * MiB;
constexpr size_t WS_ROWTOK = 4 * MiB;
constexpr size_t WS_RSTD = 5 * MiB;
constexpr size_t WS_SSA = 996 * MiB, WS_SSB = 1000 * MiB;
constexpr size_t WS_PBALL = 932 * MiB;
constexpr size_t WS_W = 6 * MiB;
constexpr size_t WL_STRIDE = 14 * MiB, WL_WIN = 0, WL_WOUT = 7 * MiB, WL_PGATE = 9 * MiB, WL_PPROJ = 11 * MiB, WL_CW1 = 11 * MiB + 512 * 1024;
constexpr size_t WS_WDENSE = WS_W + 2 * WL_STRIDE;
constexpr size_t WS_WMOE = WS_WDENSE + 22 * MiB;
constexpr size_t WE_STRIDE = 21 * MiB, WE_DOWN = 14 * MiB;
constexpr size_t WS_XN = 224 * MiB;
constexpr size_t WS_RETS = WS_XN, WS_VST = WS_XN + 64 * MiB, WS_VWT = WS_XN + 80 * MiB, WS_HIDC = WS_XN + 96 * MiB, WS_KCMP = WS_XN + 104 * MiB, WS_VCMPT = WS_XN + 105 * MiB;
constexpr size_t WS_Z = 352 * MiB;
constexpr size_t WS_HID = WS_Z;
constexpr size_t WS_YP = WS_Z + 306 * MiB;
constexpr size_t WS_PP = WS_Z;
constexpr size_t WS_AR = 800 * MiB;
constexpr size_t WS_END = 1004 * MiB;
static_assert(WS_YP + (size_t)MAXROWS * D * 2 <= WS_PBALL && (size_t)RPANELS_MAX * 256 * DFF * 2 <= 306 * MiB && 3 * RPANELS_MAX >= MAXROWS / 256, "MoE buffers fit");
static_assert(WS_WMOE + NE * WE_STRIDE <= WS_XN, "weights fit");

constexpr int RING_BYTES = 131072;
constexpr int GTAB_OFF = RING_BYTES;
constexpr int RTAB_OFF = GTAB_OFF + 16384;
constexpr int UINFO_OFF = RTAB_OFF + 15360;
constexpr int MISC_OFF = UINFO_OFF + 512;
constexpr int LDS_BYTES = MISC_OFF + 128;
static_assert(LDS_BYTES <= 163840, "LDS");
constexpr int NWAVES = 8, NTHR = 512;
#ifndef PHMASK
#define PHMASK 0xFFFFFFFFu
#endif
#ifndef REPMASK
#define REPMASK 0u
#endif
#define PH(k) if constexpr (((PHMASK) >> (k)) & 1u) for (int rep_ = 0; rep_ < ((((REPMASK) >> (k)) & 1u) ? 2 : 1); ++rep_)

DI unsigned pk(float lo, float hi) { f32x2 v = {lo, hi}; bf16x2_t b = __builtin_convertvector(v, bf16x2_t); return __builtin_bit_cast(unsigned, b); }
DI float bflo(unsigned u) { return __uint_as_float(u << 16); }
DI float bfhi(unsigned u) { return __uint_as_float(u & 0xffff0000u); }
DI float bf2f(bf16 h) { return __uint_as_float(((unsigned)h) << 16); }
typedef int i32x8 __attribute__((ext_vector_type(8)));
typedef int i32x4_t __attribute__((ext_vector_type(4)));
DI unsigned pk8(float a, float b, float c, float d) {
    a = __builtin_fminf(__builtin_fmaxf(a, -448.f), 448.f); b = __builtin_fminf(__builtin_fmaxf(b, -448.f), 448.f); c = __builtin_fminf(__builtin_fmaxf(c, -448.f), 448.f); d = __builtin_fminf(__builtin_fmaxf(d, -448.f), 448.f);
    int w = 0; w = __builtin_amdgcn_cvt_pk_fp8_f32(a, b, w, false); w = __builtin_amdgcn_cvt_pk_fp8_f32(c, d, w, true); return (unsigned)w;
}
#ifndef F8_DENSE
#define F8_DENSE 0
#endif
#ifndef F8_IN1
#define F8_IN1 0
#endif
#ifndef F8_DUP
#define F8_DUP 0
#endif
#ifndef F8_DDN
#define F8_DDN 1
#endif
#ifndef F8_GATE
#define F8_GATE 1
#endif
#ifndef F8_MOE
#define F8_MOE 1
#endif
constexpr float S8_H = 8.f, S8_WU = 32.f, S8_HID = 8.f, S8_WD = 64.f, S8_Y = 16.f;
DI float wave_sum(float v) {
#pragma unroll
    for (int o = 1; o < 64; o <<= 1) v += __shfl_xor(v, o);
    return v;
}
DI float fexp2(float x) { return __builtin_amdgcn_exp2f(x); }
DI float frcp(float x) { return __builtin_amdgcn_rcpf(x); }
DI float sigmoidf_(float x) { return frcp(1.f + fexp2(-x * LOG2E)); }
DI float siluf_(float x) { return x * sigmoidf_(x); }
DI bf16x8 mk8(unsigned a, unsigned b, unsigned c, unsigned d) { u32x4 w = {a, b, c, d}; return __builtin_bit_cast(bf16x8, w); }
#define MFMA16(a, b, c) __builtin_amdgcn_mfma_f32_16x16x32_bf16((a), (b), (c), 0, 0, 0)
typedef short s16x4 __attribute__((ext_vector_type(4)));
DI s16x4 ldtr(const LAS unsigned char* p) { return __builtin_bit_cast(s16x4, __builtin_amdgcn_ds_read_tr16_b64_v4i16((LAS s16x4*)p)); }
DI bf16x8 tr_frag(const LAS unsigned char* img, int kgrp, int ct, int fr, int fq) {
    const LAS unsigned char* p = img + (4 * fq + (fr >> 2)) * 128 + kgrp * 4096 + ((ct ^ ((2 * (fq & 1) + (fr >> 3)) & 3)) << 5) + ((fr & 3) << 3);
    const s16x4 lo = ldtr(p), hi = ldtr(p + 2048); return (bf16x8){lo[0], lo[1], lo[2], lo[3], hi[0], hi[1], hi[2], hi[3]};
}
DI int tr_chunk(int row, int ch) { return ch ^ (2 * ((row >> 1) & 3)); }
DI void gl16(const void* gsrc, unsigned lds_dst) { unsigned keep;
    asm volatile("s_mov_b32 %0, m0\n\ts_mov_b32 m0, %2\n\ts_nop 0\n\tglobal_load_lds_dwordx4 %1, off\n\ts_mov_b32 m0, %0" : "=&s"(keep) : "v"(gsrc), "s"(lds_dst) : "memory"); }

namespace pg8 {
constexpr int BM = 256, BK = 64, HALF = 128, HTB = HALF * BK * 2, STAGE_BYTES = 8 * HTB, NXCD = 8, WGM = 8;
__host__ __device__ __forceinline__ int lds_byte(int r, int c) { const int st = (r >> 4) * 2 + (c >> 5), rr = r & 15, cc = c & 31, ob = rr * 64 + cc * 2; return st * 1024 + (ob ^ (((ob >> 9) & 1) << 5)); }
__host__ __device__ __forceinline__ void stage_rc(int b, int& R, int& C) { const int st = b / 1024, sb = b % 1024, swz = sb ^ (((sb >> 9) & 1) << 5); R = (st >> 1) * 16 + swz / 64; C = (st & 1) * 32 + (swz % 64) / 2; }
__host__ __device__ __forceinline__ int perm32(int rho) { const int n = rho >> 4, i = rho & 15; return 8 * (i >> 2) + 4 * n + (i & 3); }

struct Unit { int pm, pn, ex; };
struct Gemm { const bf16* A; const bf16* Bt; int K; int lda; int kstepA; };

struct StaticOrder {
    int nM, nN, nwg, G, c, pm0; size_t tA, tB;
    DI void init(int nM_, int nN_, int G_, int c_, size_t tA_, size_t tB_, int pm0_ = 0) { nM = nM_; nN = nN_; nwg = nM * nN; G = G_; c = c_; tA = tA_; tB = tB_; pm0 = pm0_; }
    DI bool next(int i, Unit& u) const {
        const long L = (long)i * G + c; if (L >= nwg) return false;
        int wgid = (int)L; { const int q = nwg / NXCD, r = nwg % NXCD, xcd = wgid % NXCD, off = wgid / NXCD; wgid = (xcd < r ? xcd * (q + 1) : r * (q + 1) + (xcd - r) * q) + off; }
        const int nig = WGM * nN, gid = wgid / nig, fm = gid * WGM, gsz = (nM - fm) < WGM ? (nM - fm) : WGM;
        u.pm = pm0 + fm + ((wgid % nig) % gsz); u.pn = (wgid % nig) / gsz; u.ex = 0; return true;
    }
    DI size_t a_off(const Unit& u) const { return (size_t)u.pm * tA; }
    DI size_t b_off(const Unit& u) const { return (size_t)u.pn * tB; }
};
struct PanelOrder {
    int nM, G, c; size_t tA, tB;
    DI bool next(int i, Unit& u) const { const int pm = c + (i >> 2) * G; if (pm >= nM) return false; u.pm = pm; u.pn = i & 3; u.ex = 0; return true; }
    DI size_t a_off(const Unit& u) const { return (size_t)u.pm * tA; }
    DI size_t b_off(const Unit& u) const { return (size_t)u.pn * tB; }
};
struct CmpOrder {
    int G, c;
    DI bool next(int i, Unit& u) const { const int L = i * G + c; if (L >= 64) return false; u.pm = L; u.pn = 0; u.ex = 0; return true; }
    DI size_t a_off(const Unit& u) const { const int combo = u.pm >> 4, which = combo >> 1, g = combo & 1; return ((size_t)(u.pm & 15) * 256 * 16 * ZP + (which ? Z_VC : Z_KC) + g * 64) * 2; }
    DI size_t b_off(const Unit& u) const { return (size_t)(u.pm >> 5) * 256 * 2048 * 2; }
};
struct MoeOrder {
    const LAS int* info; int n; int pm0; size_t tA, tB, eB;
    DI bool next(int i, Unit& u) const { if (i >= n) return false; u.pm = info[4 * i]; u.pn = info[4 * i + 1]; u.ex = info[4 * i + 2]; return true; }
    DI size_t a_off(const Unit& u) const { return (size_t)(u.pm - pm0) * tA; }
    DI size_t b_off(const Unit& u) const { return (size_t)u.ex * eB + (size_t)u.pn * tB; }
};

#ifndef ST_MODE
#define ST_MODE 1
#endif
template <int MODE> DI void st16(void* p, const u32x4& w) {
    if constexpr (MODE == 2) asm volatile("global_store_dwordx4 %0, %1, off sc1\n\ts_nop 1" :: "v"(p), "v"(w) : "memory");
    else if constexpr (MODE == 1) asm volatile("global_store_dwordx4 %0, %1, off nt\n\ts_nop 1" :: "v"(p), "v"(w) : "memory");
    else *(u32x4*)p = w;
}
template <int MODE> DI void st8(void* p, const u32x2& w) {
    if constexpr (MODE == 2) asm volatile("global_store_dwordx2 %0, %1, off sc1\n\ts_nop 1" :: "v"(p), "v"(w) : "memory");
    else *(u32x2*)p = w;
}
template <int MODE> DI void st16o(void* base, unsigned off, const u32x4& w) {
    if constexpr (MODE == 2) asm volatile("global_store_dwordx4 %0, %1, %2 sc1\n\ts_nop 1" :: "v"(off), "v"(w), "s"(base) : "memory");
    else *(u32x4*)((char*)base + off) = w;
}
template <int MODE> DI void st8o(void* base, unsigned off, const u32x2& w) {
    if constexpr (MODE == 2) asm volatile("global_store_dwordx2 %0, %1, %2 sc1\n\ts_nop 1" :: "v"(off), "v"(w), "s"(base) : "memory");
    else *(u32x2*)((char*)base + off) = w;
}
constexpr int ST_OUT = (ST_MODE == 2) ? 2 : 0;
DI u32x4 pair16(const u32x2& wa, const u32x2& wb) {
    const u32x2 s0 = __builtin_amdgcn_permlane16_swap(wa.x, wb.x, false, false), s1 = __builtin_amdgcn_permlane16_swap(wa.y, wb.y, false, false);
    return (u32x4){s0.x, s1.x, s0.y, s1.y};
}
template <int ACT  , int SM = 0  > struct EpiBf16 {
    static constexpr bool PERM = true;
    bf16* O; int ldc; const float* bias; int bias_shift; float osc = 1.0f; int ncv = 1 << 30;
    DI void operator()(const f32x4 (&acc)[2][2][4][2], const Unit& u, int wr, int wc, int fr, int fq, const float (&rs)[2][4]) const {
        const int row0 = u.pm * BM + wr * 64 + fr, col0 = u.pn * BM + wc * 32 + 8 * fq;
        f32x4 bv[2][2];
#pragma unroll
        for (int bj = 0; bj < 2; ++bj)
#pragma unroll
            for (int n = 0; n < 2; ++n) bv[bj][n] = (ACT == 2) ? *(const f32x4*)(bias + (size_t)(u.pm >> bias_shift) * 256 + col0 + bj * HALF + 4 * n) : (f32x4){0.f, 0.f, 0.f, 0.f};
#pragma unroll
        for (int ai = 0; ai < 2; ++ai)
#pragma unroll
            for (int m = 0; m < 4; ++m) { bf16* rowp = O + (size_t)(row0 + ai * HALF + m * 16) * ldc + col0;
#pragma unroll
                for (int bj = 0; bj < 2; ++bj) { const float r_ = rs[ai][m] * osc; f32x4 v0 = acc[ai][bj][m][0] * r_ + bv[bj][0], v1 = acc[ai][bj][m][1] * r_ + bv[bj][1];
                    if (ACT == 2) {
#pragma unroll
                        for (int e = 0; e < 4; ++e) { float x = v0[e]; float uu = 0.7978845608f * (x + 0.044715f * x * x * x); v0[e] = x * frcp(1.f + fexp2(-2.f * LOG2E * uu));
                                                      x = v1[e]; uu = 0.7978845608f * (x + 0.044715f * x * x * x); v1[e] = x * frcp(1.f + fexp2(-2.f * LOG2E * uu)); } }
                    u32x4 w; w.x = pk(v0[0], v0[1]); w.y = pk(v0[2], v0[3]); w.z = pk(v1[0], v1[1]); w.w = pk(v1[2], v1[3]);
                    if (col0 + bj * HALF < ncv) st16<SM>(rowp + bj * HALF, w); } }
    }
};
struct EpiOut8 {
    static constexpr bool PERM = true;
    unsigned char* O; int ldc; float osc;
    DI void operator()(const f32x4 (&acc)[2][2][4][2], const Unit& u, int wr, int wc, int fr, int fq, const float (&rs)[2][4]) const {
        const int row0 = u.pm * BM + wr * 64 + fr, col0 = u.pn * BM + wc * 32 + 8 * (fq & ~1);
#pragma unroll
        for (int ai = 0; ai < 2; ++ai)
#pragma unroll
            for (int bj = 0; bj < 2; ++bj) { u32x2 w[4];
#pragma unroll
                for (int m = 0; m < 4; ++m) { const f32x4 v0 = acc[ai][bj][m][0] * osc, v1 = acc[ai][bj][m][1] * osc; w[m].x = pk8(v0[0], v0[1], v0[2], v0[3]); w[m].y = pk8(v1[0], v1[1], v1[2], v1[3]); }
#pragma unroll
                for (int mp = 0; mp < 2; ++mp) { const u32x4 o16 = pair16(w[2 * mp], w[2 * mp + 1]);
                    *(u32x4*)(O + (size_t)(row0 + ai * HALF + (2 * mp + (fq & 1)) * 16) * ldc + col0 + bj * HALF) = o16; } }
    }
};
template <bool W8> struct EpiRes16 {
    static constexpr bool PERM = true;
    const bf16* base; bf16* out; float* ss; unsigned char* h8; float sc;
    DI void operator()(const f32x4 (&acc)[2][2][4][2], const Unit& u, int wr, int wc, int fr, int fq, const float (&rs)[2][4]) const {
        const int row0 = u.pm * BM + wr * 64 + fr, col0 = u.pn * BM + wc * 32 + 8 * fq;
        const unsigned o0 = ((unsigned)row0 * D + col0) * 2u;
#pragma unroll
        for (int ai = 0; ai < 2; ++ai) {
            u32x4 bb[4][2];
#pragma unroll
            for (int m = 0; m < 4; ++m)
#pragma unroll
                for (int bj = 0; bj < 2; ++bj) bb[m][bj] = *(const u32x4*)((const char*)base + (o0 + (unsigned)(((ai * HALF + m * 16) * D + bj * HALF) * 2)));
            float sqv[4]; u32x2 w8[4][2];
#pragma unroll
            for (int m = 0; m < 4; ++m) { float sq = 0.f;
#pragma unroll
                for (int bj = 0; bj < 2; ++bj) { const u32x4 b = bb[m][bj]; const f32x4 a0 = acc[ai][bj][m][0] * sc, a1 = acc[ai][bj][m][1] * sc;
                    const float h0 = bflo(b.x) + a0[0], h1 = bfhi(b.x) + a0[1], h2 = bflo(b.y) + a0[2], h3 = bfhi(b.y) + a0[3], h4 = bflo(b.z) + a1[0], h5 = bfhi(b.z) + a1[1], h6 = bflo(b.w) + a1[2], h7 = bfhi(b.w) + a1[3];
                    sq += ((h0 * h0 + h1 * h1) + (h2 * h2 + h3 * h3)) + ((h4 * h4 + h5 * h5) + (h6 * h6 + h7 * h7));
                    const unsigned o2 = o0 + (unsigned)(((ai * HALF + m * 16) * D + bj * HALF) * 2);
                    u32x4 w; w.x = pk(h0, h1); w.y = pk(h2, h3); w.z = pk(h4, h5); w.w = pk(h6, h7); st16o<ST_OUT>(out, o2, w);
                    if constexpr (W8) { w8[m][bj].x = pk8(h0 * S8_H, h1 * S8_H, h2 * S8_H, h3 * S8_H); w8[m][bj].y = pk8(h4 * S8_H, h5 * S8_H, h6 * S8_H, h7 * S8_H); } }
                sq += __shfl_xor(sq, 16); sq += __shfl_xor(sq, 32); sqv[m] = sq; }
            { const float sqm = fq == 0 ? sqv[0] : fq == 1 ? sqv[1] : fq == 2 ? sqv[2] : sqv[3]; ss[(size_t)(row0 + ai * HALF + fq * 16) * 16 + 4 * u.pn + wc] = sqm; }
            if constexpr (W8) {
#pragma unroll
                for (int mp = 0; mp < 2; ++mp)
#pragma unroll
                    for (int bj = 0; bj < 2; ++bj) { const u32x4 o16 = pair16(w8[2 * mp][bj], w8[2 * mp + 1][bj]);
                        *(u32x4*)(h8 + (size_t)(row0 + ai * HALF + (2 * mp + (fq & 1)) * 16) * D + u.pn * BM + wc * 32 + 8 * (fq & ~1) + bj * HALF) = o16; } }
        }
    }
};
struct EpiSwiGLU16 {
    static constexpr bool PERM = true;
    bf16* O; int rowsub; float sc = 1.0f;
    DI void operator()(const f32x4 (&acc)[2][2][4][2], const Unit& u, int wr, int wc, int fr, int fq, const float (&rs)[2][4]) const {
        const int row0 = u.pm * BM - rowsub + wr * 64 + fr, col0 = u.pn * HALF + wc * 32 + 8 * fq;
#pragma unroll
        for (int ai = 0; ai < 2; ++ai)
#pragma unroll
            for (int m = 0; m < 4; ++m) { f32x4 h0, h1;
#pragma unroll
                for (int e = 0; e < 4; ++e) { const float r_ = rs[ai][m] * sc; h0[e] = siluf_(acc[ai][0][m][0][e] * r_) * (acc[ai][1][m][0][e] * r_); h1[e] = siluf_(acc[ai][0][m][1][e] * r_) * (acc[ai][1][m][1][e] * r_); }
                u32x4 w; w.x = pk(h0[0], h0[1]); w.y = pk(h0[2], h0[3]); w.z = pk(h1[0], h1[1]); w.w = pk(h1[2], h1[3]);
                st16<ST_OUT>(O + (size_t)(row0 + ai * HALF + m * 16) * DFF + col0, w); }
    }
};
struct EpiSwiGLU {
    static constexpr bool PERM = true;
    unsigned char* O; int rowsub; float sc;
    DI void operator()(const f32x4 (&acc)[2][2][4][2], const Unit& u, int wr, int wc, int fr, int fq, const float (&rs)[2][4]) const {
        const int row0 = u.pm * BM - rowsub + wr * 64 + fr, col0 = u.pn * HALF + wc * 32 + 8 * (fq & ~1);
#pragma unroll
        for (int ai = 0; ai < 2; ++ai) { u32x2 w[4];
#pragma unroll
            for (int m = 0; m < 4; ++m) { f32x4 h0, h1; const float r_ = rs[ai][m] * sc, ru = r_ * S8_HID;
#pragma unroll
                for (int n = 0; n < 2; ++n)
#pragma unroll
                    for (int e = 0; e < 4; e += 2) {
                        const f32x2 g = (f32x2){acc[ai][0][m][n][e], acc[ai][0][m][n][e + 1]} * r_, u = (f32x2){acc[ai][1][m][n][e], acc[ai][1][m][n][e + 1]} * ru;
                        const f32x2 t = g * (-LOG2E); const f32x2 d = (f32x2){fexp2(t[0]), fexp2(t[1])} + 1.0f; const f32x2 h = g * (f32x2){frcp(d[0]), frcp(d[1])} * u;
                        if (n == 0) { h0[e] = h[0]; h0[e + 1] = h[1]; } else { h1[e] = h[0]; h1[e + 1] = h[1]; } }
                w[m].x = pk8(h0[0], h0[1], h0[2], h0[3]); w[m].y = pk8(h1[0], h1[1], h1[2], h1[3]); }
#pragma unroll
            for (int mp = 0; mp < 2; ++mp) { const u32x4 o16 = pair16(w[2 * mp], w[2 * mp + 1]);
                *(u32x4*)(O + (size_t)(row0 + ai * HALF + (2 * mp + (fq & 1)) * 16) * DFF + col0) = o16; } }
    }
};
struct EpiSig8 {
    static constexpr bool PERM = true;
    unsigned char* O; float osc = 1.0f;
    DI void operator()(const f32x4 (&acc)[2][2][4][2], const Unit& u, int wr, int wc, int fr, int fq, const float (&rs)[2][4]) const {
        const int row0 = u.pm * BM + wr * 64 + fr, col0 = u.pn * BM + wc * 32 + 8 * (fq & ~1);
#pragma unroll
        for (int ai = 0; ai < 2; ++ai)
#pragma unroll
            for (int bj = 0; bj < 2; ++bj) { u32x2 w[4];
#pragma unroll
                for (int m = 0; m < 4; ++m) { const float rt = rs[ai][m] * osc * (-LOG2E); unsigned p[2] = {0u, 0u};
#pragma unroll
                    for (int n = 0; n < 2; ++n)
#pragma unroll
                        for (int e = 0; e < 4; e += 2) { const f32x2 t = (f32x2){acc[ai][bj][m][n][e], acc[ai][bj][m][n][e + 1]} * rt; const f32x2 d = (f32x2){fexp2(t[0]), fexp2(t[1])} + 1.0f;
                            const f32x2 sg = (f32x2){frcp(d[0]), frcp(d[1])} * 255.0f + 0.5f;
                            p[n] = __builtin_amdgcn_cvt_pk_u8_f32(sg[0], e, p[n]); p[n] = __builtin_amdgcn_cvt_pk_u8_f32(sg[1], e + 1, p[n]); }
                    w[m].x = p[0]; w[m].y = p[1]; }
#pragma unroll
                for (int mp = 0; mp < 2; ++mp) *(u32x4*)(O + (size_t)(row0 + ai * HALF + (2 * mp + (fq & 1)) * 16) * D + col0 + bj * HALF) = pair16(w[2 * mp], w[2 * mp + 1]); }
    }
};
template <bool NORM> struct EpiPleApply {
    static constexpr bool PERM = true;
    const bf16* base; const unsigned char* SG; bf16* out; float* ss;
    DI void operator()(const f32x4 (&acc)[2][2][4][2], const Unit& u, int wr, int wc, int fr, int fq, const float (&rs)[2][4]) const {
        const int row0 = u.pm * BM + wr * 64 + fr, col0 = u.pn * BM + wc * 32 + 8 * fq;
        const unsigned o0 = ((unsigned)row0 * D + col0) * 2u;
#pragma unroll
        for (int ai = 0; ai < 2; ++ai) {
            u32x4 bb[4][2]; u32x2 sg[4][2];
#pragma unroll
            for (int m = 0; m < 4; ++m)
#pragma unroll
                for (int bj = 0; bj < 2; ++bj) bb[m][bj] = *(const u32x4*)((const char*)base + (o0 + (unsigned)(((ai * HALF + m * 16) * D + bj * HALF) * 2)));
#pragma unroll
            for (int mp = 0; mp < 2; ++mp)
#pragma unroll
                for (int bj = 0; bj < 2; ++bj) { const u32x4 L = *(const u32x4*)(SG + (size_t)(row0 + ai * HALF + (2 * mp + (fq & 1)) * 16) * D + u.pn * BM + wc * 32 + 8 * (fq & ~1) + bj * HALF);
                    const u32x2 s0 = __builtin_amdgcn_permlane16_swap(L.x, L.z, false, false), s1 = __builtin_amdgcn_permlane16_swap(L.y, L.w, false, false);
                    sg[2 * mp][bj] = (u32x2){s0.x, s1.x}; sg[2 * mp + 1][bj] = (u32x2){s0.y, s1.y}; }
            float sqv[4];
#pragma unroll
            for (int m = 0; m < 4; ++m) { f32x2 sq2 = {0.f, 0.f};
#pragma unroll
                for (int bj = 0; bj < 2; ++bj) { const u32x4 b = bb[m][bj]; const u32x2 g8 = sg[m][bj]; const f32x4 a0 = acc[ai][bj][m][0], a1 = acc[ai][bj][m][1];
                    f32x2 hh[4];
#pragma unroll
                    for (int j = 0; j < 4; ++j) { const unsigned bw = j == 0 ? b.x : j == 1 ? b.y : j == 2 ? b.z : b.w; const unsigned gw = (j < 2) ? g8.x : g8.y; const int sh = 16 * (j & 1);
                        const f32x2 a2 = (j < 2) ? (f32x2){a0[2 * j], a0[2 * j + 1]} : (f32x2){a1[2 * j - 4], a1[2 * j - 3]};
                        const f32x2 sv = (f32x2){(float)((gw >> sh) & 0xffu), (float)((gw >> (sh + 8)) & 0xffu)} * (1.0f / 255.0f);
                        hh[j] = (f32x2){bflo(bw), bfhi(bw)} + a2 * sv;
                        if (NORM) sq2 = sq2 + hh[j] * hh[j]; }
                    const unsigned o2 = o0 + (unsigned)(((ai * HALF + m * 16) * D + bj * HALF) * 2);
                    u32x4 w; w.x = pk(hh[0][0], hh[0][1]); w.y = pk(hh[1][0], hh[1][1]); w.z = pk(hh[2][0], hh[2][1]); w.w = pk(hh[3][0], hh[3][1]); st16o<ST_OUT>(out, o2, w); }
                if (NORM) { float sq = sq2[0] + sq2[1]; sq += __shfl_xor(sq, 16); sq += __shfl_xor(sq, 32); sqv[m] = sq; } }
            if (NORM) { const float sqm = fq == 0 ? sqv[0] : fq == 1 ? sqv[1] : fq == 2 ? sqv[2] : sqv[3]; ss[(size_t)(row0 + ai * HALF + fq * 16) * 16 + 4 * u.pn + wc] = sqm; }
        }
    }
};
template <bool NORM> struct EpiPleGate {
    static constexpr bool PERM = true;
    const bf16* base; const bf16* PP; bf16* out; float* ss; unsigned char* h8 = nullptr;
    DI void operator()(const f32x4 (&acc)[2][2][4][2], const Unit& u, int wr, int wc, int fr, int fq, const float (&rs)[2][4]) const {
        const int row0 = u.pm * BM + wr * 64 + fr, col0 = u.pn * BM + wc * 32 + 8 * fq;
        const unsigned o0 = ((unsigned)row0 * D + col0) * 2u;
#pragma unroll
        for (int ai = 0; ai < 2; ++ai) {
            u32x4 bb[4][2], pq[4][2];
#pragma unroll
            for (int m = 0; m < 4; ++m)
#pragma unroll
                for (int bj = 0; bj < 2; ++bj) { const unsigned o2 = o0 + (unsigned)(((ai * HALF + m * 16) * D + bj * HALF) * 2); bb[m][bj] = *(const u32x4*)((const char*)base + o2); pq[m][bj] = *(const u32x4*)((const char*)PP + o2); }
            float sqv[4];
#pragma unroll
            for (int m = 0; m < 4; ++m) { float sq = 0.f; const float r_ = rs[ai][m];
#pragma unroll
                for (int bj = 0; bj < 2; ++bj) { const unsigned o2 = o0 + (unsigned)(((ai * HALF + m * 16) * D + bj * HALF) * 2); const u32x4 b = bb[m][bj], pp = pq[m][bj]; const f32x4 a0 = acc[ai][bj][m][0], a1 = acc[ai][bj][m][1];
                    const float h0 = bflo(b.x) + bflo(pp.x) * sigmoidf_(a0[0] * r_), h1 = bfhi(b.x) + bfhi(pp.x) * sigmoidf_(a0[1] * r_), h2 = bflo(b.y) + bflo(pp.y) * sigmoidf_(a0[2] * r_), h3 = bfhi(b.y) + bfhi(pp.y) * sigmoidf_(a0[3] * r_);
                    const float h4 = bflo(b.z) + bflo(pp.z) * sigmoidf_(a1[0] * r_), h5 = bfhi(b.z) + bfhi(pp.z) * sigmoidf_(a1[1] * r_), h6 = bflo(b.w) + bflo(pp.w) * sigmoidf_(a1[2] * r_), h7 = bfhi(b.w) + bfhi(pp.w) * sigmoidf_(a1[3] * r_);
                    if (NORM) sq += ((h0 * h0 + h1 * h1) + (h2 * h2 + h3 * h3)) + ((h4 * h4 + h5 * h5) + (h6 * h6 + h7 * h7));
                    u32x4 w; w.x = pk(h0, h1); w.y = pk(h2, h3); w.z = pk(h4, h5); w.w = pk(h6, h7); st16o<ST_OUT>(out, o2, w);
                    if constexpr (NORM && F8_IN1) { u32x2 w8; w8.x = pk8(h0 * S8_H, h1 * S8_H, h2 * S8_H, h3 * S8_H); w8.y = pk8(h4 * S8_H, h5 * S8_H, h6 * S8_H, h7 * S8_H); *(u32x2*)(h8 + (o2 >> 1)) = w8; } }
                if (NORM) { sq += __shfl_xor(sq, 16); sq += __shfl_xor(sq, 32); sqv[m] = sq; } }
            if (NORM) { const float sqm = fq == 0 ? sqv[0] : fq == 1 ? sqv[1] : fq == 2 ? sqv[2] : sqv[3]; ss[(size_t)(row0 + ai * HALF + fq * 16) * 16 + 4 * u.pn + wc] = sqm; }
        }
    }
};

#ifndef PROBE_REP
#define PROBE_REP 1
#endif
template <class E> constexpr int epi_rep = 1;
template <> constexpr int epi_rep<EpiBf16<0, ST_MODE>> = PROBE_REP;
template <class Epi, class Sched, bool GATHER, int RS = 0, bool F8 = false>
DI void gemm_phase(int tid_in, LAS unsigned char* lds, const Gemm g, const Sched& S, const Epi& E, const LAS int* gtab, const LAS float* rtab = nullptr) {
    int tid_ = tid_in; asm volatile("" : "+v"(tid_));
    const int tid = tid_, wid = __builtin_amdgcn_readfirstlane(tid >> 6), lane = tid & 63, wr = wid >> 2, wc = wid & 3, fr = lane & 15, fq = lane >> 4;
    const int K = g.K, nt = K / BK;
    unsigned vB[2], vA[2][2]; int rA[2]; unsigned cC[2];
#pragma unroll
    for (int i = 0; i < 2; ++i) { int R, C; stage_rc(tid * 16 + i * 8192, R, C); const int Rb = Epi::PERM ? ((R & ~31) + perm32(R & 31)) : R;
        rA[i] = R; cC[i] = (unsigned)C * 2u; vB[i] = (unsigned)(Rb * K + C) * 2u;
        vA[0][i] = (unsigned)(R * g.lda + C) * 2u; vA[1][i] = vA[0][i]; }
    const size_t kstepA = (size_t)g.kstepA, kstepB = (size_t)(BK * 2), hstepB = (size_t)HALF * K * 2, hstepA = GATHER ? (size_t)0 : (size_t)HALF * g.lda * 2;
    const unsigned ldsw = (unsigned)wid * 1024u;
    const int aoff = lds_byte(wr * 64 + fr, fq * 8), boff = lds_byte(wc * 32 + fr, fq * 8);
#define PG8_SA(b, h) (((b) * 2 + (h)) * HTB)
#define PG8_SB(b, h) ((4 + (b) * 2 + (h)) * HTB)
#define PG8_STAGE(bufoff, gbase, voff) do { _Pragma("unroll") for (int _i = 0; _i < 2; ++_i) \
        __builtin_amdgcn_global_load_lds((const unsigned*)((const char*)(gbase) + (voff)[_i]), (LAS unsigned*)(lds + (bufoff) + ldsw + _i * 8192), 16, 0, 0); } while (0)
#define PG8_LDA(dst, b, h) do { _Pragma("unroll") for (int m = 0; m < 4; ++m) _Pragma("unroll") for (int k = 0; k < 2; ++k) dst[m][k] = *(const LAS bf16x8*)(lds + PG8_SA(b, h) + aoff + m * 2048 + k * 1024); } while (0)
#define PG8_LDB(dst, b, h) do { _Pragma("unroll") for (int n = 0; n < 2; ++n) _Pragma("unroll") for (int k = 0; k < 2; ++k) dst[n][k] = *(const LAS bf16x8*)(lds + PG8_SB(b, h) + boff + n * 2048 + k * 1024); } while (0)
#define PG8_CAT(x0, x1) __builtin_shufflevector(__builtin_bit_cast(i32x4_t, (x0)), __builtin_bit_cast(i32x4_t, (x1)), 0, 1, 2, 3, 4, 5, 6, 7)
#define PG8_MMA(ai, bj, At, Bt) do { __builtin_amdgcn_s_setprio(1); _Pragma("unroll") for (int m = 0; m < 4; ++m) _Pragma("unroll") for (int n = 0; n < 2; ++n) { \
        if constexpr (F8) asm volatile("v_mfma_f32_16x16x128_f8f6f4 %0, %1, %2, %0" : "+v"(acc[ai][bj][m][n]) : "v"(PG8_CAT(Bt[n][0], Bt[n][1])), "v"(PG8_CAT(At[m][0], At[m][1]))); \
        else { _Pragma("unroll") for (int k = 0; k < 2; ++k) acc[ai][bj][m][n] = __builtin_amdgcn_mfma_f32_16x16x32_bf16(Bt[n][k], At[m][k], acc[ai][bj][m][n], 0, 0, 0); } } \
        __builtin_amdgcn_s_setprio(0); } while (0)
#define PG8_WAIT_V(n) asm volatile("s_waitcnt vmcnt(" #n ")" ::: "memory")
#define PG8_WAIT_L(n) asm volatile("s_waitcnt lgkmcnt(" #n ")" ::: "memory")
#define PG8_BAR __builtin_amdgcn_s_barrier()
#define PG8_SCHED __builtin_amdgcn_sched_barrier(0)
#define PG8_GROWS(dst, slot) do { if constexpr (GATHER) { _Pragma("unroll") for (int _h = 0; _h < 2; ++_h) _Pragma("unroll") for (int _i = 0; _i < 2; ++_i) \
        dst[_h][_i] = (unsigned)gtab[(slot) * 256 + _h * HALF + rA[_i]] * (unsigned)(g.lda * 2) + cC[_i]; } } while (0)
    Unit cur, nxt; int ui = 0;
    if (!S.next(0, cur)) return;
    f32x4 acc[2][2][4][2];
#pragma unroll
    for (int a = 0; a < 2; ++a)
#pragma unroll
        for (int b = 0; b < 2; ++b)
#pragma unroll
            for (int m = 0; m < 4; ++m)
#pragma unroll
                for (int n = 0; n < 2; ++n) acc[a][b][m][n] = (f32x4){0.f, 0.f, 0.f, 0.f};
    bf16x8 At[4][2], B0[2][2], B1[2][2];
    const char* cA = (const char*)g.A + S.a_off(cur); const char* cB = (const char*)g.Bt + S.b_off(cur);
    PG8_GROWS(vA, 0);
    int rslot = 0;
#define PG8_LOADRS() do { _Pragma("unroll") for (int _a = 0; _a < 2; ++_a) _Pragma("unroll") for (int _m = 0; _m < 4; ++_m) \
        rs[_a][_m] = (RS == 1) ? rtab[rslot * 256 + _a * HALF + wr * 64 + _m * 16 + fr] : 1.0f; } while (0)
    PG8_STAGE(PG8_SB(0, 0), cB, vB); PG8_STAGE(PG8_SB(0, 1), cB + hstepB, vB); PG8_STAGE(PG8_SA(0, 0), cA, vA[0]); PG8_STAGE(PG8_SA(0, 1), cA + hstepA, vA[1]);
    if (wr == 1) PG8_BAR;
    PG8_WAIT_V(2); PG8_BAR;
    PG8_STAGE(PG8_SB(1, 0), cB + kstepB, vB); PG8_STAGE(PG8_SA(1, 0), cA + kstepA, vA[0]); PG8_STAGE(PG8_SB(1, 1), cB + hstepB + kstepB, vB);
    PG8_WAIT_V(6); PG8_BAR;
    for (;;) {
        const bool has_next = S.next(ui + 1, nxt);
        const char* nA = has_next ? (const char*)g.A + S.a_off(nxt) : cA; const char* nB = has_next ? (const char*)g.Bt + S.b_off(nxt) : cB;

#pragma nounroll
        for (int t = 0; t < nt; t += 2) {
            const bool last = (t == nt - 2);
            const char* a1 = cA + (size_t)(t + 1) * kstepA;
            const char* a2 = last ? nA : cA + (size_t)(t + 2) * kstepA; const char* b2 = last ? nB : cB + (size_t)(t + 2) * kstepB;
            const char* a3 = a2 + kstepA; const char* b3 = b2 + kstepB;
            PG8_LDB(B0, 0, 0); PG8_LDB(B1, 0, 1); PG8_SCHED; PG8_LDA(At, 0, 0); PG8_STAGE(PG8_SA(1, 1), a1 + hstepA, vA[1]);
            PG8_WAIT_V(8); PG8_WAIT_L(0); PG8_BAR; PG8_MMA(0, 0, At, B0); PG8_MMA(0, 1, At, B1); PG8_BAR; PG8_SCHED;
            if constexpr (GATHER) { if (last && has_next) { PG8_GROWS(vA, rslot + (nxt.pm != cur.pm ? 1 : 0)); } }
            PG8_LDA(At, 0, 1); PG8_STAGE(PG8_SB(0, 0), b2, vB); PG8_STAGE(PG8_SB(0, 1), b2 + hstepB, vB); PG8_STAGE(PG8_SA(0, 0), a2, vA[0]);
            PG8_WAIT_V(8); PG8_WAIT_L(0); PG8_BAR; PG8_MMA(1, 0, At, B0); PG8_MMA(1, 1, At, B1); PG8_BAR; PG8_SCHED;
            PG8_LDB(B0, 1, 0); PG8_LDB(B1, 1, 1); PG8_SCHED; PG8_LDA(At, 1, 0); PG8_STAGE(PG8_SA(0, 1), a2 + hstepA, vA[1]);
            PG8_WAIT_V(8); PG8_WAIT_L(0); PG8_BAR; PG8_MMA(0, 0, At, B0); PG8_MMA(0, 1, At, B1); PG8_BAR; PG8_SCHED;
            PG8_LDA(At, 1, 1); PG8_STAGE(PG8_SB(1, 0), b3, vB); PG8_STAGE(PG8_SB(1, 1), b3 + hstepB, vB); PG8_STAGE(PG8_SA(1, 0), a3, vA[0]);
            PG8_WAIT_V(8); PG8_WAIT_L(0); PG8_BAR; PG8_MMA(1, 0, At, B0); PG8_MMA(1, 1, At, B1); PG8_BAR; PG8_SCHED;
        }
        if constexpr (F8) asm volatile("s_nop 15\n\ts_nop 15" ::: "memory");
        if (wr == 0) PG8_BAR;
        float rs[2][4];
        PG8_LOADRS();
#pragma unroll
        for (int er = 0; er < epi_rep<Epi>; ++er) E(acc, cur, wr, wc, fr, fq, rs);
        if (!has_next) break;
#pragma unroll
        for (int a = 0; a < 2; ++a)
#pragma unroll
            for (int b = 0; b < 2; ++b)
#pragma unroll
                for (int m = 0; m < 4; ++m)
#pragma unroll
                    for (int n = 0; n < 2; ++n) acc[a][b][m][n] = (f32x4){0.f, 0.f, 0.f, 0.f};
        if (nxt.pm != cur.pm) ++rslot;
        cur = nxt; cA = nA; cB = nB; ++ui;
        if (wr == 1) PG8_BAR;
    }
    PG8_WAIT_V(0);
    PG8_BAR;
#undef PG8_SA
#undef PG8_SB
#undef PG8_STAGE
#undef PG8_LDA
#undef PG8_LDB
#undef PG8_MMA
#undef PG8_CAT
#undef PG8_WAIT_V
#undef PG8_WAIT_L
#undef PG8_BAR
#undef PG8_SCHED
#undef PG8_GROWS
#undef PG8_LOADRS
}
}

#define XB_TMO      128
#define XB_XCNT(j)  (256  + 64 * (j))
#define XB_XSUB(j)  (1280 + 64 * (j))
#define XB_XGEN(j)  (2304 + 64 * (j))
#define XB_TOP      3328
#define XB_TOPGEN   3392
#define XCD_BAR_WORDS 3456
#define XB_SPIN_CAP (1u << 22)
DI unsigned xb_ld(unsigned* p)              { return __hip_atomic_load(p, __ATOMIC_RELAXED, __HIP_MEMORY_SCOPE_AGENT); }
DI unsigned xb_add(unsigned* p, unsigned v) { return __hip_atomic_fetch_add(p, v, __ATOMIC_RELAXED, __HIP_MEMORY_SCOPE_AGENT); }
DI int lane_now() { unsigned z = 0u; asm volatile("" : "+v"(z)); return (int)__builtin_amdgcn_mbcnt_hi(~0u, __builtin_amdgcn_mbcnt_lo(~0u, z)); }
DI unsigned xb_xcc_id() { return (unsigned)__builtin_amdgcn_s_getreg((3 << 11) | 20) & 0xFu; }
#define XB_SPIN(cond, bar) do { unsigned _sp = 0; while (cond) { __builtin_amdgcn_s_sleep(1); \
    if ((++_sp & 255u) == 0u) { if (xb_ld(&(bar)[XB_TMO])) break; if (_sp > XB_SPIN_CAP) { atomicAdd(&(bar)[XB_TMO], 1u); break; } } } } while (0)
struct XcdBarrier { unsigned* bar; unsigned x; volatile LAS unsigned* st; };
DI XcdBarrier xcd_barrier_post(unsigned* bar, volatile LAS unsigned* st, int wave0) {
    XcdBarrier b; b.bar = bar; b.x = xb_xcc_id(); b.st = st;
    if ((wave0 * 64 + lane_now()) == 0) (void)xb_add(&bar[XB_XCNT(b.x)], 1u);
    return b;
}
DI void xcd_barrier_complete(unsigned* bar, unsigned x, unsigned& nloc, unsigned& nx) {
    const unsigned G = gridDim.x * gridDim.y * gridDim.z;
    unsigned sum, cnt, mine, sp = 0u;
    for (;;) {
        sum = 0u; cnt = 0u; mine = 0u;
#pragma unroll
        for (unsigned j = 0; j < 16; ++j) { const unsigned c = xb_ld(&bar[XB_XCNT(j)]); sum += c; cnt += (c > 0u) ? 1u : 0u; mine = (j == x) ? c : mine; }
        if (sum == G) break;
        __builtin_amdgcn_s_sleep(1);
        if ((++sp & 255u) == 0u) { if (xb_ld(&bar[XB_TMO])) break; if (sp > XB_SPIN_CAP) { atomicAdd(&bar[XB_TMO], 1u); break; } }
    }
    nloc = mine > 0u ? mine : 1u; nx = cnt > 0u ? cnt : 1u;
}
DI void xcd_barrier(const XcdBarrier& b, int wave0) {
    asm volatile("s_waitcnt vmcnt(0)" ::: "memory");
    __syncthreads();
    if ((wave0 * 64 + lane_now()) == 0) {
        unsigned bx = b.x; GAS unsigned* barg = (GAS unsigned*)b.bar; asm volatile("" : "+s"(bx), "+s"(barg)); unsigned* bar = (unsigned*)barg;
        __builtin_amdgcn_s_waitcnt(0);
        unsigned nloc = b.st[0], nx = b.st[1];
        if (nloc == 0u) { xcd_barrier_complete(bar, bx, nloc, nx); b.st[0] = nloc; b.st[1] = nx; }
        const unsigned old = xb_add(&bar[XB_XSUB(bx)], 1u);
        const unsigned gen = old / nloc;
        if (old + 1u == (gen + 1u) * nloc) {
            __builtin_amdgcn_fence(__ATOMIC_RELEASE, "agent");
            asm volatile("s_waitcnt vmcnt(0)" ::: "memory");
            const unsigned og = xb_add(&bar[XB_TOP], 1u);
            const unsigned tg = og / nx;
            if (og + 1u == (tg + 1u) * nx) xb_add(&bar[XB_TOPGEN], 1u);
            else XB_SPIN(xb_ld(&bar[XB_TOPGEN]) == tg, bar);
            __builtin_amdgcn_fence(__ATOMIC_ACQUIRE, "agent");
            xb_add(&bar[XB_XGEN(bx)], 1u);
            asm volatile("s_waitcnt vmcnt(0)" ::: "memory");
        } else {
            XB_SPIN(xb_ld(&bar[XB_XGEN(bx)]) == gen, bar);
            __builtin_amdgcn_fence(__ATOMIC_ACQUIRE, "agent");
            asm volatile("s_waitcnt vmcnt(0)" ::: "memory");
        }
    }
    __syncthreads();
}

struct Args { const float* in[21]; float* out; unsigned char* ws; };
enum { I_X = 0, I_P, I_WIN, I_WOUT, I_GMIX, I_GFFN, I_GPLE, I_GFINAL, I_CPOS, I_CW1, I_CW2, I_RETGN, I_FGATE, I_FUP, I_FDOWN, I_ROUTER, I_MGATE, I_MUP, I_MDOWN, I_PPROJ, I_PGATE };
struct Frame { LAS unsigned char* lds; unsigned char* ws; int tid, lane, wave, G, bid, wave0; };

DI void relaunder(Frame& F) { int w = __builtin_amdgcn_readfirstlane(F.wave0), l = lane_now(); asm volatile("" : "+s"(w), "+v"(l)); F.wave0 = w; F.tid = w * 64 + l; F.lane = l; F.wave = w;
    int g = (int)gridDim.x, b = (int)blockIdx.x; asm volatile("" : "+s"(g), "+s"(b)); F.G = g; F.bid = b; }

struct Seg { const float* src; bf16* dst; int K, Nsrc, nsrc0, ncols, nvalid, ndst0, ilv; const float* gain; int f8; float wsc; };
constexpr int NSEG = 2 * 8 + 3 + NE * 3;
DI Seg seg_decode(const Args& a, int s) {
    Seg g; unsigned char* ws = a.ws;
    if (s < 16) { const int L = s >> 3, k = s & 7; unsigned char* wl = ws + WS_W + L * WL_STRIDE;
        if (k == 0) g = Seg{a.in[I_WIN] + (size_t)L * D * IN_COLS, (bf16*)(wl + WL_WIN), D, IN_COLS, 0, 1280, 1280, 0, 0, a.in[I_GMIX] + L * D, (F8_IN1 && L == 1) ? 1 : 0, S8_WU};
        else if (k == 1) g = Seg{a.in[I_WIN] + (size_t)L * D * IN_COLS, (bf16*)(wl + WL_WIN), D, IN_COLS, 1304, 2048, 2048, 1280, 0, a.in[I_GMIX] + L * D, (F8_IN1 && L == 1) ? 1 : 0, S8_WU};
        else if (k == 2) g = Seg{a.in[I_WIN] + (size_t)L * D * IN_COLS, (bf16*)(wl + WL_WIN), D, IN_COLS, 1280, 256, 24, 3328, 0, a.in[I_GMIX] + L * D, (F8_IN1 && L == 1) ? 1 : 0, S8_WU};
        else if (k == 3) g = Seg{a.in[I_WOUT] + (size_t)L * D * D, (bf16*)(wl + WL_WOUT), D, D, 0, D, D, 0, 0, nullptr};
        else if (k == 4) g = Seg{a.in[I_PGATE] + (size_t)L * D * D, (bf16*)(wl + WL_PGATE), D, D, 0, D, D, 0, 0, a.in[I_GPLE] + L * D, F8_GATE, S8_WU};
        else if (k == 5) g = Seg{a.in[I_PPROJ] + (size_t)L * PLE * D, (bf16*)(wl + WL_PPROJ), PLE, D, 0, D, D, 0, 0, nullptr};
        else { const int which = k - 6; g = Seg{a.in[I_CW1] + (size_t)(L * 2 + which) * 2048 * 256, (bf16*)(wl + WL_CW1) + (size_t)which * 256 * 2048, 2048, 256, 0, 256, 256, 0, 0, nullptr}; }
    } else if (s < 19) { const int k = s - 16;
        if (k == 0) g = Seg{a.in[I_FGATE], (bf16*)(ws + WS_WDENSE), D, DFF, 0, DFF, DFF, 0, 1, a.in[I_GFFN], F8_DUP, S8_WU};
        else if (k == 1) g = Seg{a.in[I_FUP], (bf16*)(ws + WS_WDENSE), D, DFF, 0, DFF, DFF, 0, 2, a.in[I_GFFN], F8_DUP, S8_WU};
        else g = Seg{a.in[I_FDOWN], (bf16*)(ws + WS_WDENSE + 14 * MiB), DFF, D, 0, D, D, 0, 0, nullptr, F8_DDN, S8_WD};
    } else { const int e = (s - 19) / 3, k = (s - 19) % 3; unsigned char* we = ws + WS_WMOE + (size_t)e * WE_STRIDE;
        if (k == 0) g = Seg{a.in[I_MGATE] + (size_t)e * D * DFF, (bf16*)we, D, DFF, 0, DFF, DFF, 0, 1, a.in[I_GFFN] + D, F8_MOE, S8_WU};
        else if (k == 1) g = Seg{a.in[I_MUP] + (size_t)e * D * DFF, (bf16*)we, D, DFF, 0, DFF, DFF, 0, 2, a.in[I_GFFN] + D, F8_MOE, S8_WU};
        else g = Seg{a.in[I_MDOWN] + (size_t)e * DFF * D, (bf16*)(we + WE_DOWN), DFF, D, 0, D, D, 0, 0, nullptr, F8_MOE, S8_WD};
    }
    return g;
}
DI void transpose_load(const Seg& g, int item, int lane, f32x4 (&r)[8]) {
    const int nblk = g.ncols / 32, kb = item / nblk, nb = item % nblk, k0 = 64 * kb, n0 = 32 * nb;
    const int c4 = (lane & 7) * 4; const int nv = g.nvalid - n0;
#pragma unroll
    for (int i = 0; i < 8; ++i) { const int kk = i * 8 + (lane >> 3); r[i] = (c4 < nv) ? *(const f32x4*)(g.src + (size_t)(k0 + kk) * g.Nsrc + g.nsrc0 + n0 + c4) : (f32x4){0.f, 0.f, 0.f, 0.f};
        if (g.gain) r[i] = r[i] * g.gain[k0 + kk]; }
}
DI void transpose_store(const Seg& g, LAS float* scr, int item, int lane, const f32x4 (&r)[8]) {
    const int nblk = g.ncols / 32, kb = item / nblk, nb = item % nblk, k0 = 64 * kb, n0 = 32 * nb;
    const int c4 = (lane & 7) * 4;
#pragma unroll
    for (int i = 0; i < 8; ++i) { const int kk = i * 8 + (lane >> 3); LAS float* d = scr + kk * 33 + c4; d[0] = r[i][0]; d[1] = r[i][1]; d[2] = r[i][2]; d[3] = r[i][3]; }
    asm volatile("s_waitcnt lgkmcnt(0)" ::: "memory");
    const int c8 = lane & 7;
#pragma unroll
    for (int j = 0; j < 4; ++j) { const int n = (lane >> 3) + 8 * j; const LAS float* s = scr + (8 * c8) * 33 + n;
        const int na = n0 + n; const int drow = g.ilv ? ((na >> 7) * 256 + (na & 127) + (g.ilv == 2 ? 128 : 0)) : (g.ndst0 + na);
        if (g.f8) { const float c = g.wsc; u32x2 o; o.x = pk8(s[0 * 33] * c, s[1 * 33] * c, s[2 * 33] * c, s[3 * 33] * c); o.y = pk8(s[4 * 33] * c, s[5 * 33] * c, s[6 * 33] * c, s[7 * 33] * c);
            *(u32x2*)((unsigned char*)g.dst + (size_t)drow * g.K + k0 + 8 * c8) = o; }
        else { u32x4 o; o.x = pk(s[0 * 33], s[1 * 33]); o.y = pk(s[2 * 33], s[3 * 33]); o.z = pk(s[4 * 33], s[5 * 33]); o.w = pk(s[6 * 33], s[7 * 33]);
            *(u32x4*)(g.dst + (size_t)drow * g.K + k0 + 8 * c8) = o; } }
    asm volatile("s_waitcnt lgkmcnt(0)" ::: "memory");
}

DI void row_load(const float* row, int lane, f32x4 (&v)[4]) {
#pragma unroll
    for (int j = 0; j < 4; ++j) v[j] = *(const f32x4*)(row + 4 * lane + 256 * j);
}
DI float row_rstd(const f32x4 (&v)[4]) {
    float s = 0.f;
#pragma unroll
    for (int j = 0; j < 4; ++j) s += (v[j][0] * v[j][0] + v[j][1] * v[j][1]) + (v[j][2] * v[j][2] + v[j][3] * v[j][3]);
    return 1.0f / sqrtf(wave_sum(s) * (1.f / D) + EPS);
}
DI void row_store_bf16(bf16* orow, int lane, const f32x4 (&y)[4]) {
#pragma unroll
    for (int j = 0; j < 4; ++j) { u32x2 w; w.x = pk(y[j][0], y[j][1]); w.y = pk(y[j][2], y[j][3]); *(u32x2*)(orow + 4 * lane + 256 * j) = w; }
}
DI void row_load16(const bf16* row, int lane, f32x4 (&v)[4]) {
#pragma unroll
    for (int j = 0; j < 4; ++j) { const u32x2 w = *(const u32x2*)(row + 4 * lane + 256 * j); v[j] = (f32x4){bflo(w.x), bfhi(w.x), bflo(w.y), bfhi(w.y)}; }
}
DI void norm_first(Frame& F, const float* src, bf16* H16, float* rstd) {
    const int gw = F.bid * NWAVES + F.wave, NGW = F.G * NWAVES;
    for (int m = gw; m < T; m += NGW) { f32x4 v[4]; row_load(src + (size_t)m * D, F.lane, v); const float r = row_rstd(v);
        row_store_bf16(H16 + (size_t)m * D, F.lane, v); if (F.lane == 0) rstd[m] = r; }
}
DI void pb_convert(Frame& F, const float* p, bf16* PBo) {
    const size_t n8 = (size_t)2 * T * PLE / 8;
    for (size_t i = (size_t)F.bid * NTHR + F.tid; i < n8; i += (size_t)F.G * NTHR) { const f32x4 a = *(const f32x4*)(p + 8 * i), b = *(const f32x4*)(p + 8 * i + 4);
        u32x4 w; w.x = pk(a[0], a[1]); w.y = pk(a[2], a[3]); w.z = pk(b[0], b[1]); w.w = pk(b[2], b[3]); *(u32x4*)(PBo + 8 * i) = w; }
}
DI void norm_final(Frame& F, const bf16* H16, const float* gain, float* out) {
    f32x4 gv[4]; row_load(gain, F.lane, gv);
    const int gw = F.bid * NWAVES + F.wave, NGW = F.G * NWAVES;
    for (int m = gw; m < T; m += NGW) { f32x4 v[4]; row_load16(H16 + (size_t)m * D, F.lane, v); const float r = row_rstd(v);
#pragma unroll
        for (int j = 0; j < 4; ++j) *(f32x4*)(out + (size_t)m * D + 4 * F.lane + 256 * j) = v[j] * r * gv[j]; }
}
template <bool FROM_SS, class Sched> DI void fill_rtab(Frame& F, const Sched& S, LAS float* rtab, const float* src) {
    LAS int* ui = (LAS int*)(F.lds + UINFO_OFF);
    pg8::Unit u; int ns = 0, last = -1;
    for (int i = 0; S.next(i, u); ++i) if (u.pm != last) { last = u.pm; if (ns < 15 && F.tid == 0) ui[4 * ns + 3] = u.pm; ++ns; }
    __syncthreads();
    const int nsl = ns < 15 ? ns : 15, r = F.tid & 255, s0 = F.tid >> 8;
    for (int sb = 0; sb < nsl; sb += 8) {
        f32x4 q[4][4]; float rr[4];
#pragma unroll
        for (int j = 0; j < 4; ++j) { const int sl = sb + s0 + 2 * j; if (sl < nsl) { const size_t row = (size_t)ui[4 * sl + 3] * 256 + r;
            if (FROM_SS) { const f32x4* p = (const f32x4*)(src + row * 16); q[j][0] = p[0]; q[j][1] = p[1]; q[j][2] = p[2]; q[j][3] = p[3]; } else rr[j] = src[row]; } }
#pragma unroll
        for (int j = 0; j < 4; ++j) { const int sl = sb + s0 + 2 * j; if (sl < nsl) { float rv;
            if (FROM_SS) { const f32x4 a = q[j][0], b = q[j][1], c = q[j][2], d = q[j][3];
                float t = 0.f; t += a[0]; t += a[1]; t += a[2]; t += a[3]; t += b[0]; t += b[1]; t += b[2]; t += b[3]; t += c[0]; t += c[1]; t += c[2]; t += c[3]; t += d[0]; t += d[1]; t += d[2]; t += d[3];
                rv = 1.0f / sqrtf(t * (1.f / D) + EPS); }
            else rv = rr[j];
            rtab[sl * 256 + r] = rv; } }
    }
    __syncthreads();
}
DI float rstd_from_ss(const float* ss, int row) { const f32x4* p = (const f32x4*)(ss + (size_t)row * 16); const f32x4 a = p[0], b = p[1], c = p[2], d = p[3];
    float t = 0.f; t += a[0]; t += a[1]; t += a[2]; t += a[3]; t += b[0]; t += b[1]; t += b[2]; t += b[3]; t += c[0]; t += c[1]; t += c[2]; t += c[3]; t += d[0]; t += d[1]; t += d[2]; t += d[3];
    return 1.0f / sqrtf(t * (1.f / D) + EPS); }
DI void moe_combine(Frame& F, bf16* H16, unsigned char* G8, float* rstd, const unsigned char* YP, const int* tokrow, const float* tokinfo) {
    const int gw = F.bid * NWAVES + F.wave, NGW = F.G * NWAVES;
    for (int m = gw; m < T; m += NGW) { f32x4 v[4]; row_load16(H16 + (size_t)m * D, F.lane, v);
        const int r0 = tokrow[2 * m], r1 = tokrow[2 * m + 1]; const float w0 = tokinfo[4 * m + 2] * (1.0f / S8_Y), w1 = tokinfo[4 * m + 3] * (1.0f / S8_Y);
#pragma unroll
        for (int j = 0; j < 4; ++j) { const int a = *(const int*)(YP + (size_t)r0 * D + 4 * F.lane + 256 * j), b = *(const int*)(YP + (size_t)r1 * D + 4 * F.lane + 256 * j);
            const f32x2 a0 = __builtin_amdgcn_cvt_pk_f32_fp8(a, false), a1 = __builtin_amdgcn_cvt_pk_f32_fp8(a, true), b0 = __builtin_amdgcn_cvt_pk_f32_fp8(b, false), b1 = __builtin_amdgcn_cvt_pk_f32_fp8(b, true);
            v[j][0] += w0 * a0[0] + w1 * b0[0]; v[j][1] += w0 * a0[1] + w1 * b0[1]; v[j][2] += w0 * a1[0] + w1 * b1[0]; v[j][3] += w0 * a1[1] + w1 * b1[1]; }
        const float r = row_rstd(v);
        row_store_bf16(H16 + (size_t)m * D, F.lane, v); if (F.lane == 0) rstd[m] = r;
        if (F8_GATE) {
#pragma unroll
            for (int j = 0; j < 4; ++j) *(unsigned*)(G8 + (size_t)m * D + 4 * F.lane + 256 * j) = pk8(v[j][0] * S8_H, v[j][1] * S8_H, v[j][2] * S8_H, v[j][3] * S8_H); } }
}
DI void norm_router(Frame& F, const bf16* H16, const float* gain, const float* router, float* tokinfo, int* bcnt) {
    LAS int* sel = (LAS int*)(F.lds + 32768);
    LAS float* wts = (LAS float*)(F.lds + 32768 + 1024);
    LAS int* pib = (LAS int*)(F.lds + 32768 + 1024 + 2048);
    f32x4 gv[4]; row_load(gain, F.lane, gv);
    f32x4 rw[4][4][2];
#pragma unroll
    for (int j = 0; j < 4; ++j)
#pragma unroll
        for (int q = 0; q < 4; ++q) { const int c = 4 * F.lane + 256 * j + q; rw[j][q][0] = *(const f32x4*)(router + c * 8); rw[j][q][1] = *(const f32x4*)(router + c * 8 + 4); }
    for (int blk = F.bid; blk < T / 256; blk += F.G) {
        for (int i = 0; i < 32; ++i) { const int rl = F.wave * 32 + i, m = blk * 256 + rl; f32x4 v[4]; row_load16(H16 + (size_t)m * D, F.lane, v); const float r = row_rstd(v);
            float lg[NE];
#pragma unroll
            for (int e = 0; e < NE; ++e) lg[e] = 0.f;
#pragma unroll
            for (int j = 0; j < 4; ++j) { v[j] = v[j] * r * gv[j];
#pragma unroll
                for (int q = 0; q < 4; ++q) { const f32x4 r0 = rw[j][q][0], r1 = rw[j][q][1];
                    lg[0] += v[j][q] * r0[0]; lg[1] += v[j][q] * r0[1]; lg[2] += v[j][q] * r0[2]; lg[3] += v[j][q] * r0[3]; lg[4] += v[j][q] * r1[0]; lg[5] += v[j][q] * r1[1]; lg[6] += v[j][q] * r1[2]; lg[7] += v[j][q] * r1[3]; } }
#pragma unroll
            for (int e = 0; e < NE; ++e) lg[e] = wave_sum(lg[e]);
            int e0 = 0; float v0 = lg[0];
#pragma unroll
            for (int e = 1; e < NE; ++e) if (lg[e] > v0) { v0 = lg[e]; e0 = e; }
            int e1 = -1; float v1 = -3.0e38f;
#pragma unroll
            for (int e = 0; e < NE; ++e) if (e != e0 && lg[e] > v1) { v1 = lg[e]; e1 = e; }
            const float w0 = 1.f / (1.f + __expf(v1 - v0));
            if (F.lane == 0) { sel[rl] = e0 | (e1 << 8); wts[2 * rl] = w0; wts[2 * rl + 1] = 1.f - w0; }
        }
        __syncthreads();
        LAS int* p0 = pib; LAS int* p1 = pib + 256;
        if (F.tid < NE) { const int e = F.tid; int cnt = 0;
            for (int rl = 0; rl < 256; ++rl) { const int s = sel[rl]; if ((s & 255) == e) p0[rl] = cnt++; if ((s >> 8) == e) p1[rl] = cnt++; }
            bcnt[blk * NE + e] = cnt; }
        __syncthreads();
        if (F.tid < 256) { const int m = blk * 256 + F.tid; f32x4 o; o[0] = __int_as_float(sel[F.tid]); o[1] = __int_as_float(p0[F.tid] | (p1[F.tid] << 16)); o[2] = wts[2 * F.tid]; o[3] = wts[2 * F.tid + 1]; *(f32x4*)(tokinfo + 4 * (size_t)m) = o; }
        __syncthreads();
    }
}
DI void moe_index(Frame& F, const int* bcnt, const float* tokinfo, int* tokrow, int* rowtok, int* meta) {
    LAS int* C = (LAS int*)F.lds;
    LAS int* tot = C + 2048; LAS int* base = tot + 8; LAS int* off = base + 8;
    for (int i = F.tid; i < 2048; i += NTHR) C[i] = bcnt[i];
    __syncthreads();
    for (int blk = F.bid; blk < T / 256; blk += F.G) {
        if (F.tid < NE) { int t = 0, b = 0; for (int k = 0; k < 256; ++k) { const int c = C[k * NE + F.tid]; if (k < blk) b += c; t += c; } tot[F.tid] = t; base[F.tid] = b; }
        __syncthreads();
        if (F.tid == 0) { int o = 0; for (int e = 0; e < NE; ++e) { off[e] = o; o += (tot[e] + 255) & ~255; } off[NE] = o; }
        __syncthreads();
        if (F.tid < 256) { const int m = blk * 256 + F.tid; const f32x4 ti = *(const f32x4*)(tokinfo + 4 * (size_t)m); const int s = __float_as_int(ti[0]), pp = __float_as_int(ti[1]);
            const int e0 = s & 255, e1 = s >> 8; const int r0 = off[e0] + base[e0] + (pp & 0xffff), r1 = off[e1] + base[e1] + (pp >> 16);
            rowtok[r0] = m; rowtok[r1] = m; tokrow[2 * m] = r0; tokrow[2 * m + 1] = r1; }
        if (blk < NE) { const int e = blk; for (int r = tot[e] + F.tid; r < ((tot[e] + 255) & ~255); r += NTHR) rowtok[off[e] + r] = 0; }
        if (blk == 0) { const int np = off[NE] >> 8; if (F.tid == 0) meta[0] = np;
            for (int p = F.tid; p < np; p += NTHR) { int e = 0;
#pragma unroll
                for (int k = 1; k < NE; ++k) if (p * 256 >= off[k]) e = k;
                meta[16 + p] = e; } }
        __syncthreads();
    }
}

DI int slot_of(int key) { const int kl = key & 31; return (key & ~31) + 8 * ((kl >> 2) & 3) + 4 * (kl >> 4) + (kl & 3); }
DI float log2_gamma(int h) { return log2f(1.0f - exp2f(-5.0f - (float)h)); }
struct RetKV { u32x4 k[2], v[2]; };
DI void ret_kv_load(Frame& F, const bf16* Z, int unit, RetKV& r) {
    const int bh = unit >> 6, c = unit & 63, b = bh >> 3, h = bh & 7; const size_t row0 = (size_t)b * SEQ + c * 128;
#pragma unroll
    for (int i = 0; i < 2; ++i) { const int p = i * 512 + F.tid, m = p >> 3, ch = p & 7;
        r.k[i] = *(const u32x4*)(Z + (row0 + m) * ZP + Z_KR + h * 64 + 8 * ch); r.v[i] = *(const u32x4*)(Z + (row0 + m) * ZP + Z_VR + h * 64 + 8 * ch); }
}
DI void ret_kv_compute(Frame& F, float* RETS, int unit, const RetKV& r, bool has_next, const bf16* Z, int next_unit, RetKV& rn) {
    const int h = (unit >> 6) & 7; const float lg = log2_gamma(h);
    LAS unsigned char* KI = F.lds; LAS unsigned char* VI = F.lds + 16384;
#pragma unroll
    for (int i = 0; i < 2; ++i) { const int p = i * 512 + F.tid, m = p >> 3, ch = p & 7;
        const float sc = 0.125f * fexp2((float)(127 - m) * lg);
        u32x4 kk; kk.x = pk(bflo(r.k[i].x) * sc, bfhi(r.k[i].x) * sc); kk.y = pk(bflo(r.k[i].y) * sc, bfhi(r.k[i].y) * sc); kk.z = pk(bflo(r.k[i].z) * sc, bfhi(r.k[i].z) * sc); kk.w = pk(bflo(r.k[i].w) * sc, bfhi(r.k[i].w) * sc);
        const int o = m * 128 + (tr_chunk(m, ch) << 4); *(LAS u32x4*)(KI + o) = kk; *(LAS u32x4*)(VI + o) = r.v[i]; }
    __syncthreads();
    if (has_next) ret_kv_load(F, Z, next_unit, rn);
    const int fr = F.lane & 15, fq = F.lane >> 4;
#pragma unroll
    for (int tt = 0; tt < 2; ++tt) { const int tile = 2 * F.wave + tt, et = tile >> 2, dt = tile & 3; f32x4 acc = {0.f, 0.f, 0.f, 0.f};
#pragma unroll
        for (int ks = 0; ks < 4; ++ks) acc = MFMA16(tr_frag(VI, ks, et, fr, fq), tr_frag(KI, ks, dt, fr, fq), acc);
        float* o = RETS + ((size_t)unit * 64) * 64;
#pragma unroll
        for (int v = 0; v < 4; ++v) o[(16 * et + 4 * fq + v) * 64 + 16 * dt + fr] = acc[v]; }
    __syncthreads();
}
DI void ret_kv_units(Frame& F, const bf16* Z, float* RETS, int u0, int step, int n) {
    if (n <= 0) return;
    RetKV ra, rb; ret_kv_load(F, Z, u0, ra);
#pragma nounroll
    for (int i = 0; i < n; ++i) { ret_kv_compute(F, RETS, u0 + i * step, ra, i + 1 < n, Z, u0 + (i + 1) * step, rb); ra = rb; }
}
DI void ret_scan(Frame& F, float* RETS) {
    for (int e = F.bid * NTHR + F.tid; e < 64 * 4096; e += F.G * NTHR) { const int bh = e >> 12, idx = e & 4095, h = bh & 7; const float gc = fexp2(128.f * log2_gamma(h));
        float* p = RETS + (size_t)bh * 64 * 4096 + idx; float st = 0.f;
        for (int c0 = 0; c0 < 64; c0 += 8) { float kv[8];
#pragma unroll
            for (int j = 0; j < 8; ++j) kv[j] = p[(size_t)(c0 + j) * 4096];
#pragma unroll
            for (int j = 0; j < 8; ++j) { p[(size_t)(c0 + j) * 4096] = st; st = gc * st + kv[j]; } } }
}
DI void cmp_out(Frame& F, const bf16* HIDC, const float* w2  , bf16* KCMP, bf16* VCMPT) {
    LAS bf16* WT = (LAS bf16*)F.lds; const int fr = F.lane & 15, fq = F.lane >> 4; int have = -1;
    for (int rb = F.bid; rb < 16384 / 64; rb += F.G) { const int R0 = rb * 64, combo = R0 >> 12, which = combo >> 1, g = combo & 1;
        if (which != have) { __syncthreads();
#pragma unroll
            for (int i = 0; i < 8; ++i) { const int e = (i * 512 + F.tid) * 4, k = e >> 6, d0 = e & 63; const f32x4 w = *(const f32x4*)(w2 + (size_t)which * 16384 + e);
                const unsigned p0 = pk(w[0], w[1]), p1 = pk(w[2], w[3]); WT[(d0 + 0) * 264 + k] = (bf16)(p0 & 0xffff); WT[(d0 + 1) * 264 + k] = (bf16)(p0 >> 16); WT[(d0 + 2) * 264 + k] = (bf16)(p1 & 0xffff); WT[(d0 + 3) * 264 + k] = (bf16)(p1 >> 16); }
            have = which; __syncthreads(); }
        const int rt = F.wave & 3, row = R0 + 16 * rt + fr; f32x4 acc[2] = {{0.f, 0.f, 0.f, 0.f}, {0.f, 0.f, 0.f, 0.f}};
#pragma unroll
        for (int ks = 0; ks < 8; ++ks) { const bf16x8 a = *(const bf16x8*)(HIDC + (size_t)row * 256 + 32 * ks + 8 * fq);
#pragma unroll
            for (int c = 0; c < 2; ++c) { const int ct = 2 * (F.wave >> 2) + c; const bf16x8 bb = *(const LAS bf16x8*)(WT + (16 * ct + fr) * 264 + 32 * ks + 8 * fq); acc[c] = MFMA16(a, bb, acc[c]); } }
        const int rq = R0 + 16 * rt + 4 * fq, bn = rq & 4095, bq = bn >> 9, n0 = bn & 511, bg = bq * 2 + g;
#pragma unroll
        for (int c = 0; c < 2; ++c) { const int dd = 16 * (2 * (F.wave >> 2) + c) + fr; float v4[4];
#pragma unroll
            for (int v = 0; v < 4; ++v) v4[v] = (n0 + v == 511) ? 0.f : acc[c][v];
            if (which == 0) {
#pragma unroll
                for (int v = 0; v < 4; ++v) KCMP[((size_t)bg * 512 + n0 + v) * 64 + dd] = (bf16)(pk(v4[v], 0.f) & 0xffff); }
            else {
#pragma unroll
                for (int v = 0; v < 4; ++v) VCMPT[((size_t)bg * 512 + n0 + v) * 64 + dd] = (bf16)(pk(v4[v], 0.f) & 0xffff); } }
    }
    __syncthreads();
}

namespace rto { constexpr int RAWK = 0, RAWV = 32768, RAWS = 65536, STO = RAWS + 16384, END = STO + 64 * 72 * 2; static_assert(END <= RING_BYTES, "ret_out lds"); }
DI void ret_out_dma(Frame& F, const bf16* Z, const float* RETS, int unit, int kbuf) {
    const int bh = unit >> 6, c = unit & 63, b = bh >> 3, h = bh & 7; const size_t row0 = (size_t)b * SEQ + c * 128;
    const unsigned l0 = (unsigned)(uintptr_t)F.lds;
#pragma unroll
    for (int j = 0; j < 2; ++j) { const int p = 2 * F.wave + j, row = 8 * p + (F.lane >> 3), cl = F.lane & 7;
        gl16((const char*)(Z + (row0 + row) * ZP + Z_KR + h * 64) + ((cl ^ ((row >> 1) & 7)) << 4), (unsigned)__builtin_amdgcn_readfirstlane(l0 + rto::RAWK + kbuf * 16384 + p * 1024));
        gl16((const char*)(Z + (row0 + row) * ZP + Z_VR + h * 64) + (tr_chunk(row, cl) << 4), (unsigned)__builtin_amdgcn_readfirstlane(l0 + rto::RAWV + kbuf * 16384 + p * 1024));
        gl16((const char*)(RETS + (size_t)unit * 4096) + p * 1024 + F.lane * 16, (unsigned)__builtin_amdgcn_readfirstlane(l0 + rto::RAWS + p * 1024)); }
}
DI int ret_out_unit(Frame& F, const bf16* Z, const float* RETS, const float* gn, bf16* AR, int unit, int kbuf, unsigned* qctr, LAS int* qslot) {
    int grabbed = 0; if (F.tid == 0) grabbed = (int)__hip_atomic_fetch_add(qctr, 1u, __ATOMIC_RELAXED, __HIP_MEMORY_SCOPE_AGENT);
    const int bh = unit >> 6, c = unit & 63, b = bh >> 3, h = bh & 7; const float lg = log2_gamma(h);
    const LAS unsigned char* Kl = F.lds + rto::RAWK + kbuf * 16384;
    const LAS unsigned char* VI = F.lds + rto::RAWV + kbuf * 16384;
    LAS bf16* ST = (LAS bf16*)(F.lds + rto::STO);
    const size_t row0 = (size_t)b * SEQ + c * 128;
    const int fr = F.lane & 15, fq = F.lane >> 4, w = F.wave, n = 16 * w + fr;
    bf16x8 q[2];
#pragma unroll
    for (int ks = 0; ks < 2; ++ks) q[ks] = *(const bf16x8*)(Z + (row0 + n) * ZP + Z_QR + h * 64 + 32 * ks + 8 * fq);
    u32x2 gsave[4];
#pragma unroll
    for (int et = 0; et < 4; ++et) gsave[et] = *(const u32x2*)(Z + (row0 + n) * ZP + Z_GR + h * 64 + 16 * et + 4 * fq);
    __builtin_amdgcn_s_waitcnt(0);
    __syncthreads();
    { const int e = F.tid >> 3, d0 = (F.tid & 7) * 8; const f32x4 s0 = *(const LAS f32x4*)(F.lds + rto::RAWS + (e * 64 + d0) * 4), s1 = *(const LAS f32x4*)(F.lds + rto::RAWS + (e * 64 + d0 + 4) * 4);
      u32x4 wv; wv.x = pk(s0[0], s0[1]); wv.y = pk(s0[2], s0[3]); wv.z = pk(s1[0], s1[1]); wv.w = pk(s1[2], s1[3]); *(LAS u32x4*)(ST + e * 72 + d0) = wv; }
    if (F.tid == 0) qslot[0] = grabbed;
    asm volatile("s_waitcnt lgkmcnt(0)" ::: "memory");
    __syncthreads();
    const int nq = F.G + __builtin_amdgcn_readfirstlane(qslot[0]);
    if (nq < 2048 + 4096) ret_out_dma(F, Z, RETS, nq - 2048, kbuf ^ 1);
    f32x4 s[8];
#pragma unroll
    for (int mt = 0; mt < 8; ++mt) { s[mt] = (f32x4){0.f, 0.f, 0.f, 0.f};
        if (mt <= w) {
#pragma unroll
            for (int ks = 0; ks < 2; ++ks) { const bf16x8 a = *(const LAS bf16x8*)(Kl + (16 * mt + fr) * 128 + (((4 * ks + fq) ^ ((fr >> 1) & 7)) << 4)); s[mt] = MFMA16(a, q[ks], s[mt]); }
#pragma unroll
            for (int v = 0; v < 4; ++v) { const int m = 16 * mt + 4 * fq + v; const int df = n - m; s[mt][v] = (df >= 0) ? s[mt][v] * 0.125f * fexp2((float)df * lg) : 0.f; } } }
    f32x4 o1[4], o2[4];
#pragma unroll
    for (int et = 0; et < 4; ++et) { o1[et] = (f32x4){0.f, 0.f, 0.f, 0.f}; o2[et] = (f32x4){0.f, 0.f, 0.f, 0.f}; }
#pragma unroll
    for (int pg = 0; pg < 4; ++pg) if (2 * pg <= w) { const bf16x8 pb = mk8(pk(s[2 * pg][0], s[2 * pg][1]), pk(s[2 * pg][2], s[2 * pg][3]), pk(s[2 * pg + 1][0], s[2 * pg + 1][1]), pk(s[2 * pg + 1][2], s[2 * pg + 1][3]));
#pragma unroll
        for (int et = 0; et < 4; ++et) o1[et] = MFMA16(tr_frag(VI, pg, et, fr, fq), pb, o1[et]); }
#pragma unroll
    for (int ks = 0; ks < 2; ++ks)
#pragma unroll
        for (int et = 0; et < 4; ++et) { const bf16x8 a = *(const LAS bf16x8*)(ST + (16 * et + fr) * 72 + 32 * ks + 8 * fq); o2[et] = MFMA16(a, q[ks], o2[et]); }
    const float xi = fexp2((float)(n + 1) * lg);
    float sum = 0.f;
#pragma unroll
    for (int et = 0; et < 4; ++et) { o1[et] = o1[et] + o2[et] * xi; sum += (o1[et][0] + o1[et][1]) + (o1[et][2] + o1[et][3]); }
    sum += __shfl_xor(sum, 16); sum += __shfl_xor(sum, 32);
    const float mu = sum * (1.f / 64.f); float var = 0.f;
#pragma unroll
    for (int et = 0; et < 4; ++et) { o1[et] = o1[et] - mu; var += (o1[et][0] * o1[et][0] + o1[et][1] * o1[et][1]) + (o1[et][2] * o1[et][2] + o1[et][3] * o1[et][3]); }
    var += __shfl_xor(var, 16); var += __shfl_xor(var, 32);
    const float rs = 1.0f / sqrtf(var * (1.f / 64.f) + EPS);
#pragma unroll
    for (int et = 0; et < 4; ++et) { const int e0 = 16 * et + 4 * fq; const f32x4 gg = *(const f32x4*)(gn + h * 64 + e0); const u32x2 gr = gsave[et];
        const float y0 = o1[et][0] * rs * gg[0] * siluf_(bflo(gr.x)), y1 = o1[et][1] * rs * gg[1] * siluf_(bfhi(gr.x)), y2 = o1[et][2] * rs * gg[2] * siluf_(bflo(gr.y)), y3 = o1[et][3] * rs * gg[3] * siluf_(bfhi(gr.y));
        u32x2 wv; wv.x = pk(y0, y1); wv.y = pk(y2, y3); *(u32x2*)(AR + (row0 + n) * D + 512 + h * 64 + e0) = wv; }
    return nq - F.G;
}

namespace nsa {
constexpr int KP = 128, STG = 2 * 64 * KP, NSTG = 4;
constexpr int OFF_IMPA = NSTG * STG, OFF_IMPB = OFF_IMPA + 32768, OFF_SEL = OFF_IMPB + 32768, OFF_WU = OFF_SEL + 1024, NEED = OFF_WU + 128;
static_assert(NEED <= GTAB_OFF + 16384, "nsa lds");
constexpr float THR = 6.0f;
struct Ctx { LAS unsigned char* lds; const bf16* Z; const bf16* KCMP; const bf16* VCMPT; int tid, lane, wave, fr, fq, b, g, bg, cur; size_t tb; };
typedef unsigned long long u64;
struct M128 { u64 lo, hi; };
DI bool get_bit(const M128& w, int i) { const u64 x = (i < 64) ? w.lo : w.hi; return ((x >> (i & 63)) & 1ull) != 0ull; }
DI void set_bit(M128& w, int i) { const u64 b = 1ull << (i & 63); if (i < 64) w.lo |= b; else w.hi |= b; }
DI int last_bit(const M128& w, int upto) {
    if (upto < 0) return -1;
    u64 x = (upto >= 64) ? (w.hi & (~0ull >> (63 - (upto & 63)))) : 0ull;
    if (x) return 127 - __builtin_clzll(x);
    x = (upto >= 64) ? w.lo : (w.lo & (~0ull >> (63 - upto)));
    if (x) return 63 - __builtin_clzll(x);
    return -1;
}
typedef short s16x4 __attribute__((ext_vector_type(4)));
DI s16x4 vtr(const LAS unsigned char* p) { return __builtin_bit_cast(s16x4, __builtin_amdgcn_ds_read_tr16_b64_v4i16((LAS s16x4*)p)); }
DI float xq_max(float v) { auto a = __builtin_amdgcn_permlane16_swap(__float_as_uint(v), __float_as_uint(v), false, false); v = fmaxf(__uint_as_float(a[0]), __uint_as_float(a[1]));
    auto b = __builtin_amdgcn_permlane32_swap(__float_as_uint(v), __float_as_uint(v), false, false); return fmaxf(__uint_as_float(b[0]), __uint_as_float(b[1])); }
DI float xq_sum(float v) { auto a = __builtin_amdgcn_permlane16_swap(__float_as_uint(v), __float_as_uint(v), false, false); v = __uint_as_float(a[0]) + __uint_as_float(a[1]);
    auto b = __builtin_amdgcn_permlane32_swap(__float_as_uint(v), __float_as_uint(v), false, false); return __uint_as_float(b[0]) + __uint_as_float(b[1]); }
DI float quad_sum(float v) { v += __int_as_float(__builtin_amdgcn_mov_dpp(__float_as_int(v), 0xB1, 0xf, 0xf, true)); v += __int_as_float(__builtin_amdgcn_mov_dpp(__float_as_int(v), 0x4E, 0xf, 0xf, true)); return v; }
DI void glds16(const void* gsrc, unsigned lds_dst) { unsigned keep;
    asm volatile("s_mov_b32 %0, m0\n\ts_mov_b32 m0, %2\n\ts_nop 0\n\tglobal_load_lds_dwordx4 %1, off\n\ts_mov_b32 m0, %0" : "=&s"(keep) : "v"(gsrc), "s"(lds_dst) : "memory"); }
template <int MODE> DI void src_ptrs(const Ctx& X, int m, const char*& kp, size_t& kpitch, const char*& vp) {
    if (MODE <= 1) { kp = (const char*)(X.KCMP + ((size_t)X.bg * 512 + 64 * m) * 64); kpitch = 128; vp = (const char*)(X.VCMPT + ((size_t)X.bg * 512 + 64 * m) * 64); }
    else if (MODE == 2) { kp = (const char*)(X.Z + (X.tb + 64 * m) * ZP + Z_KS + 64 * X.g); kpitch = (size_t)ZP * 2; vp = (const char*)(X.Z + (X.tb + 64 * m) * ZP + Z_VS + 64 * X.g); }
    else { kp = (const char*)(X.Z + (X.tb + 64 * m) * ZP + Z_KW + 64 * X.g); kpitch = (size_t)ZP * 2; vp = (const char*)(X.Z + (X.tb + 64 * m) * ZP + Z_VW + 64 * X.g); }
}
template <int MODE, bool MASKED>
DI void cg_block(const bf16x8 (&kf)[4][2], const bf16x8 (&q)[2], const f32x4& base0, float sl2, float kpos0, int fq4, int lim, bool inv, bool selbit,
                 float& mr, float& lr, f32x4 (&o)[4], bf16x8 (&pb)[2], LAS float* impA, LAS float* impB, int mg0, bool impw, int fr, int fq) {
    const bool use = (MODE == 2) ? selbit : true;
    const float kstep = sl2 * ((MODE <= 1) ? 256.f : 16.f);
    const float blk = use ? (sl2 * kpos0 - mr) : -__builtin_inff();
    f32x4 s[4];
#pragma unroll
    for (int kt = 0; kt < 4; ++kt) { s[kt] = base0 + (blk + kstep * (float)kt);
        if (MASKED) {
#pragma unroll
            for (int v = 0; v < 4; ++v) s[kt][v] = (((16 * kt + fq4 + v) <= lim) != inv) ? s[kt][v] : -__builtin_inff(); }
#pragma unroll
        for (int ks = 0; ks < 2; ++ks) s[kt] = MFMA16(kf[kt][ks], q[ks], s[kt]); }
    f32x2 ps2 = {0.f, 0.f};
#pragma unroll
    for (int kt = 0; kt < 4; ++kt) {
#pragma unroll
        for (int v = 0; v < 4; ++v) s[kt][v] = fexp2(s[kt][v]);
        ps2 = ps2 + (f32x2){s[kt][0], s[kt][1]} + (f32x2){s[kt][2], s[kt][3]};
        if (MODE == 1) { const float A = quad_sum((s[kt][0] + s[kt][1]) + (s[kt][2] + s[kt][3])), B = quad_sum(s[kt][3]);
            if (impw) { impA[mg0 + 4 * kt] = A; if ((mg0 & 127) + 4 * kt + 1 < 128) impB[mg0 + 4 * kt + 1] = B; } } }
    if (MODE != 1) lr += ps2.x + ps2.y;
    if (MODE != 0) {
#pragma unroll
        for (int kg = 0; kg < 2; ++kg) pb[kg] = mk8(pk(s[2 * kg][0], s[2 * kg][1]), pk(s[2 * kg][2], s[2 * kg][3]), pk(s[2 * kg + 1][0], s[2 * kg + 1][1]), pk(s[2 * kg + 1][2], s[2 * kg + 1][3])); }
}
template <int MODE> DI bool blk_masked(int m, int cur) { return (MODE <= 1) ? (64 * m + 63 > 4 * cur - 2) : (MODE == 2 ? (m == cur) : (m == cur || m == cur - 8)); }
template <int MODE>
DI void do_block(const Ctx& X, int m, int st, const bf16x8 (&q)[2][2], const int (&tq)[2], float sl2, const f32x4& base, int xfr, int xfq,
                 float (&mr)[2], float (&lr)[2], f32x4 (&o)[2][4], const M128& cgU0, const M128& cgU1, const M128& selw0, const M128& selw1) {
    const int cur = X.cur, fq4 = 4 * xfq;
    LAS float* impA = (LAS float*)(X.lds + OFF_IMPA); LAS float* impB = (LAS float*)(X.lds + OFF_IMPB);
    const bool needw = (MODE == 2) ? (get_bit(cgU0, m) || get_bit(cgU1, m)) : true;
    if (!needw) return;
    const LAS unsigned char* Kl = X.lds + st * STG; const LAS unsigned char* Vl = Kl + 64 * KP;
    const bool inv = (MODE == 3) && (m == cur - 8);
    const float kpos0 = (MODE <= 1) ? (float)(1024 * m + 31) : (float)(64 * m);
    const bool masked = blk_masked<MODE>(m, cur);
    bf16x8 kf[4][2];
#pragma unroll
    for (int kt = 0; kt < 4; ++kt)
#pragma unroll
        for (int ks = 0; ks < 2; ++ks) kf[kt][ks] = *(const LAS bf16x8*)(Kl + (16 * kt + xfr) * KP + (((4 * ks + xfq) ^ ((xfr >> 1) & 7)) << 4));
    bf16x8 pb[2][2];
#pragma unroll
    for (int cg = 0; cg < 2; ++cg) {
        const int lim = (MODE <= 1) ? (((tq[cg] - 31) >> 4) - 64 * m) : (tq[cg] - 64 * cur);
        const bool selbit = (MODE == 2) ? get_bit(cg == 0 ? selw0 : selw1, m) : true;
        const int tokl = 8 * X.wave + 4 * cg + (xfr >> 2); const int mg0 = tokl * 128 + 16 * m + xfq; const bool impw = (xfr & 3) == 0;
        if (masked) cg_block<MODE, true>(kf, q[cg], base, sl2, kpos0, fq4, lim, inv, selbit, mr[cg], lr[cg], o[cg], pb[cg], impA, impB, mg0, impw, xfr, xfq);
        else cg_block<MODE, false>(kf, q[cg], base, sl2, kpos0, fq4, lim, inv, selbit, mr[cg], lr[cg], o[cg], pb[cg], impA, impB, mg0, impw, xfr, xfq);
    }
    if (MODE != 0) {
#pragma unroll
        for (int kg = 0; kg < 2; ++kg)
#pragma unroll
            for (int dt = 0; dt < 4; ++dt) {
                const LAS unsigned char* vp0 = Vl + (4 * xfq + (xfr >> 2)) * KP + kg * 4096 + ((dt ^ ((2 * (xfq & 1) + (xfr >> 3)) & 3)) << 5) + ((xfr & 3) << 3);
                const s16x4 lo = vtr(vp0), hi = vtr(vp0 + 2048);
                const bf16x8 a = (bf16x8){lo[0], lo[1], lo[2], lo[3], hi[0], hi[1], hi[2], hi[3]};
                o[0][dt] = MFMA16(a, pb[0][kg], o[0][dt]); o[1][dt] = MFMA16(a, pb[1][kg], o[1][dt]); } }
}
template <int MODE> DI void dma_blk(const Ctx& X, int m, int stg, int ln) {
    const char* kp; size_t kpitch; const char* vp; src_ptrs<MODE>(X, m, kp, kpitch, vp);
    const int drow = 8 * X.wave + (ln >> 3), dch = ((ln & 7) ^ ((drow >> 1) & 7)) << 4;
    const unsigned lds0 = (unsigned)(uintptr_t)X.lds + (unsigned)X.wave * 1024u + (unsigned)stg * STG;
    glds16(kp + (unsigned)(drow * ((MODE <= 1) ? 128 : ZP * 2) + dch), (unsigned)__builtin_amdgcn_readfirstlane(lds0));
    const int dchv = ((ln & 7) ^ (2 * ((drow >> 1) & 3))) << 4;
    glds16(vp + (unsigned)(drow * ((MODE <= 1) ? 128 : ZP * 2) + dchv), (unsigned)__builtin_amdgcn_readfirstlane(lds0 + 8192u));
}
template <int MODE, int NMODE>
DI void run_blocks(const Ctx& X, const Ctx& XN, const M128& bm, const bf16x8 (&q)[2][2], const int (&tq)[2], float sl2, float (&mr)[2], float (&lr)[2], f32x4 (&o)[2][4],
                   const M128& cgU0, const M128& cgU1, const M128& selw0, const M128& selw1, int& hb, bool pre, int p0, int p1) {
    int ln_ = X.lane; asm volatile("" : "+v"(ln_));
    const int xfr = ln_ & 15, xfq = ln_ >> 4, fq4 = 4 * xfq;
    f32x4 base;
#pragma unroll
    for (int v = 0; v < 4; ++v) base[v] = sl2 * ((MODE <= 1) ? 16.f : 1.f) * (float)(fq4 + v);
    int m0 = last_bit(bm, 127), m1 = last_bit(bm, m0 - 1);
    while (m0 >= 0) {
        const int n0 = (m1 >= 0) ? last_bit(bm, m1 - 1) : -1, n1 = last_bit(bm, n0 - 1);
        asm volatile("s_waitcnt vmcnt(0) lgkmcnt(0)\n\ts_barrier" ::: "memory");
        if (n0 >= 0) { dma_blk<MODE>(X, n0, 2 * (hb ^ 1), ln_); if (n1 >= 0) dma_blk<MODE>(X, n1, 2 * (hb ^ 1) + 1, ln_); }
        else if (pre) { dma_blk<NMODE>(XN, p0, 2 * (hb ^ 1), ln_); if (p1 >= 0) dma_blk<NMODE>(XN, p1, 2 * (hb ^ 1) + 1, ln_); }
        do_block<MODE>(X, m0, 2 * hb, q, tq, sl2, base, xfr, xfq, mr, lr, o, cgU0, cgU1, selw0, selw1);
        if (m1 >= 0) do_block<MODE>(X, m1, 2 * hb + 1, q, tq, sl2, base, xfr, xfq, mr, lr, o, cgU0, cgU1, selw0, selw1);
        if (MODE != 1) {
#pragma unroll
            for (int cg = 0; cg < 2; ++cg) if (__any(lr[cg] > 0x1p60f)) { mr[cg] += 64.f; lr[cg] *= 0x1p-64f;
                if (MODE != 0) {
#pragma unroll
                    for (int dt = 0; dt < 4; ++dt) o[cg][dt] = o[cg][dt] * 0x1p-64f; } } }
        m0 = n0; m1 = n1; hb ^= 1;
    }
}
DI void make_ctx(Ctx& X, Frame& F, const bf16* Z, const bf16* KCMP, const bf16* VCMPT, int u) {
    X.lds = F.lds; X.Z = Z; X.KCMP = KCMP; X.VCMPT = VCMPT; X.tid = F.tid; X.lane = F.lane; X.wave = F.wave; X.fr = F.lane & 15; X.fq = F.lane >> 4;
    X.bg = u & 15; X.b = X.bg >> 1; X.g = X.bg & 1; X.cur = 127 - (u >> 4); X.tb = (size_t)X.b * SEQ;
}
constexpr int NQ = 2048;
DI int unit(Frame& F, const bf16* Z, const bf16* KCMP, const bf16* VCMPT, bf16* AR, int u, int& hb, unsigned* qctr, LAS int* qslot) {
    Ctx X, XN; make_ctx(X, F, Z, KCMP, VCMPT, u);
    int grabbed = 0; if (F.tid == 0) grabbed = (int)__hip_atomic_fetch_add(qctr, 1u, __ATOMIC_RELAXED, __HIP_MEMORY_SCOPE_AGENT);
    const int cur = X.cur, t0 = 64 * cur, r = X.fr & 3, head = 4 * X.g + r;
    const float sl2 = exp2f(-(float)(head + 1)) * LOG2E;
    int tq[2]; bf16x8 q[2][2]; float gate[2][3];
#pragma unroll
    for (int cg = 0; cg < 2; ++cg) { tq[cg] = t0 + 8 * X.wave + 4 * cg + (X.fr >> 2); const bf16* zr = Z + (X.tb + tq[cg]) * ZP;
#pragma unroll
        for (int ks = 0; ks < 2; ++ks) { const u32x4 w = *(const u32x4*)(zr + Z_QN + head * 64 + 32 * ks + 8 * X.fq); constexpr float C1 = 0.125f * LOG2E;
            q[cg][ks] = mk8(pk(bflo(w.x) * C1, bfhi(w.x) * C1), pk(bflo(w.y) * C1, bfhi(w.y) * C1), pk(bflo(w.z) * C1, bfhi(w.z) * C1), pk(bflo(w.w) * C1, bfhi(w.w) * C1)); }
#pragma unroll
        for (int br = 0; br < 3; ++br) gate[cg][br] = sigmoidf_(bf2f(zr[Z_GL + br * 8 + head])); }
    __builtin_amdgcn_s_waitcnt(0);
    f32x4 o[2][4]; float mr[2], lr[2];
    LAS f32x4* FIN = (LAS f32x4*)(X.lds + OFF_IMPA + X.wave * 8192) + X.lane;
    M128 cgU0 = {0ull, 0ull}, cgU1 = {0ull, 0ull}, selw0 = {0ull, 0ull}, selw1 = {0ull, 0ull}, bm;
    { const int jmax = (4 * cur + 2) >> 6; bm.lo = (2ull << jmax) - 1ull; bm.hi = 0ull; }
#pragma unroll
    for (int cg = 0; cg < 2; ++cg) { mr[cg] = sl2 * (float)tq[cg]; lr[cg] = 0.f;
#pragma unroll
        for (int dt = 0; dt < 4; ++dt) o[cg][dt] = (f32x4){0.f, 0.f, 0.f, 0.f}; }
    const int jm = (4 * cur + 2) >> 6;
    run_blocks<0, 1>(X, X, bm, q, tq, sl2, mr, lr, o, cgU0, cgU1, selw0, selw1, hb, true, jm, jm - 1);
#pragma unroll
    for (int cg = 0; cg < 2; ++cg) { const float lt = xq_sum(lr[cg]); mr[cg] = lt > 0.f ? mr[cg] + log2f(lt) : __builtin_inff(); }
    run_blocks<1, 2>(X, X, bm, q, tq, sl2, mr, lr, o, cgU0, cgU1, selw0, selw1, hb, true, cur, cur - 1);
#pragma unroll
    for (int cg = 0; cg < 2; ++cg)
#pragma unroll
        for (int dt = 0; dt < 4; ++dt) o[cg][dt] = o[cg][dt] * gate[cg][0];
    asm volatile("s_waitcnt lgkmcnt(0)" ::: "memory");
    {
        const LAS float* IA = (const LAS float*)(X.lds + OFF_IMPA); const LAS float* IB = (const LAS float*)(X.lds + OFF_IMPB); LAS u64* SEL = (LAS u64*)(X.lds + OFF_SEL);
        const int nforced = cur == 0 ? 1 : (cur == 1 ? 2 : 3), KK = 16 - nforced, ncand = cur - 2 > 0 ? cur - 2 : 0;
        M128 forced = {1ull, 0ull}; set_bit(forced, cur); if (cur >= 1) set_bit(forced, cur - 1);
        const int m0 = X.lane, m1 = X.lane + 64; const bool c0 = (m0 >= 1 && m0 <= cur - 2), c1 = (m1 <= cur - 2);
        M128 wu = {0ull, 0ull};
#pragma unroll 2
        for (int ti = 0; ti < 8; ++ti) { const int tok = 8 * X.wave + ti;
            const unsigned k0 = c0 ? (__float_as_uint(IA[tok * 128 + m0] + IB[tok * 128 + m0]) + 1u) : 0u, k1 = c1 ? (__float_as_uint(IA[tok * 128 + m1] + IB[tok * 128 + m1]) + 1u) : 0u;
            bool s0 = c0, s1 = c1;
            if (ncand > KK) { unsigned thr = 0u;
                for (int bit = 30; bit >= 0; --bit) { const unsigned cand = thr | (1u << bit); const int cnt = __popcll(__ballot(k0 >= cand)) + __popcll(__ballot(k1 >= cand)); if (cnt >= KK) { thr = cand; if (cnt == KK) break; } }
                const u64 g0 = __ballot(k0 > thr), g1 = __ballot(k1 > thr), e0 = __ballot(k0 == thr && c0), e1 = __ballot(k1 == thr && c1);
                const int needn = KK - (__popcll(g0) + __popcll(g1)); const u64 lt = (1ull << X.lane) - 1ull;
                const int rk0 = __popcll(e0 & lt), rk1 = __popcll(e0) + __popcll(e1 & lt);
                s0 = (k0 > thr) || (k0 == thr && c0 && rk0 < needn); s1 = (k1 > thr) || (k1 == thr && c1 && rk1 < needn); }
            const u64 wlo = __ballot(s0) | forced.lo, whi = __ballot(s1) | forced.hi;
            if (X.lane == 0) { SEL[tok * 2] = wlo; SEL[tok * 2 + 1] = whi; }
            if (ti < 4) { cgU0.lo |= wlo; cgU0.hi |= whi; } else { cgU1.lo |= wlo; cgU1.hi |= whi; }
            wu.lo |= wlo; wu.hi |= whi; }
        if (X.lane == 0) { ((LAS u64*)(X.lds + OFF_WU))[X.wave * 2] = wu.lo; ((LAS u64*)(X.lds + OFF_WU))[X.wave * 2 + 1] = wu.hi; }
        asm volatile("s_waitcnt lgkmcnt(0)" ::: "memory");
        { const int tl0 = 8 * X.wave + (X.fr >> 2), tl1 = tl0 + 4; selw0.lo = SEL[tl0 * 2]; selw0.hi = SEL[tl0 * 2 + 1]; selw1.lo = SEL[tl1 * 2]; selw1.hi = SEL[tl1 * 2 + 1]; }
        if (F.tid == 0) qslot[0] = grabbed;
        __syncthreads();
        #pragma unroll
        for (int cg = 0; cg < 2; ++cg)
#pragma unroll
            for (int dt = 0; dt < 4; ++dt) FIN[(cg * 4 + dt) * 64] = o[cg][dt];
        bm.lo = 0ull; bm.hi = 0ull;
#pragma unroll
        for (int w = 0; w < 8; ++w) { bm.lo |= ((const LAS u64*)(X.lds + OFF_WU))[w * 2]; bm.hi |= ((const LAS u64*)(X.lds + OFF_WU))[w * 2 + 1]; }
        bm.lo = ((u64)__builtin_amdgcn_readfirstlane((unsigned)(bm.lo >> 32)) << 32) | (u64)__builtin_amdgcn_readfirstlane((unsigned)bm.lo);
        bm.hi = ((u64)__builtin_amdgcn_readfirstlane((unsigned)(bm.hi >> 32)) << 32) | (u64)__builtin_amdgcn_readfirstlane((unsigned)bm.hi);
    }
    const int un = F.G + __builtin_amdgcn_readfirstlane(qslot[0]);
    make_ctx(XN, F, Z, KCMP, VCMPT, un < NQ ? un : u);
#pragma unroll
    for (int cg = 0; cg < 2; ++cg) { mr[cg] = sl2 * (float)tq[cg]; lr[cg] = 0.f;
#pragma unroll
        for (int dt = 0; dt < 4; ++dt) o[cg][dt] = (f32x4){0.f, 0.f, 0.f, 0.f}; }
    run_blocks<2, 3>(X, X, bm, q, tq, sl2, mr, lr, o, cgU0, cgU1, selw0, selw1, hb, true, cur, cur - 1);
#pragma unroll
    for (int cg = 0; cg < 2; ++cg) { const float lt = xq_sum(lr[cg]); const float sc = (lt > 0.f ? 1.0f / lt : 0.f) * gate[cg][1];
#pragma unroll
        for (int dt = 0; dt < 4; ++dt) FIN[(cg * 4 + dt) * 64] = FIN[(cg * 4 + dt) * 64] + o[cg][dt] * sc; }
    bm.lo = 0ull; bm.hi = 0ull;
    for (int mm = (cur >= 8 ? cur - 8 : 0); mm <= cur; ++mm) set_bit(bm, mm);
#pragma unroll
    for (int cg = 0; cg < 2; ++cg) { mr[cg] = sl2 * (float)tq[cg]; lr[cg] = 0.f;
#pragma unroll
        for (int dt = 0; dt < 4; ++dt) o[cg][dt] = (f32x4){0.f, 0.f, 0.f, 0.f}; }
    { const int jn = (4 * XN.cur + 2) >> 6; run_blocks<3, 0>(X, XN, bm, q, tq, sl2, mr, lr, o, cgU0, cgU1, selw0, selw1, hb, un < NQ, jn, jn - 1); }
#pragma unroll
    for (int cg = 0; cg < 2; ++cg) { const float lt = xq_sum(lr[cg]); const float sc = (lt > 0.f ? 1.0f / lt : 0.f) * gate[cg][2];
        bf16* orow = AR + (X.tb + tq[cg]) * D + head * 64;
#pragma unroll
        for (int dt = 0; dt < 4; ++dt) { const f32x4 y = FIN[(cg * 4 + dt) * 64] + o[cg][dt] * sc; u32x2 wv; wv.x = pk(y[0], y[1]); wv.y = pk(y[2], y[3]); *(u32x2*)(orow + 16 * dt + 4 * X.fq) = wv; } }
    return un - F.G;
}
}

__global__ void __launch_bounds__(NTHR, 2) hybrid_fwd(Args args) {
    extern __shared__ __attribute__((aligned(16))) unsigned char lds_raw[];
    Frame F; F.lds = (LAS unsigned char*)lds_raw; F.ws = args.ws; F.tid = threadIdx.x; F.lane = F.tid & 63; F.wave = __builtin_amdgcn_readfirstlane(F.tid >> 6); F.wave0 = F.wave; F.G = gridDim.x; F.bid = blockIdx.x;
    volatile LAS unsigned* MISC = (volatile LAS unsigned*)(F.lds + MISC_OFF);
    if (F.tid < 32) MISC[F.tid] = 0u;
    __syncthreads();
    unsigned* ctl = (unsigned*)(args.ws + WS_CTL);
    XcdBarrier bar = xcd_barrier_post(ctl + 4096, MISC + 8, F.wave0);
    unsigned char* ws = args.ws;
#define RELAUNDER() do { relaunder(F); GAS unsigned char* wsg_ = (GAS unsigned char*)ws; asm volatile("" : "+s"(wsg_)); ws = (unsigned char*)wsg_; F.ws = ws; } while (0)
#define P16 ((bf16*)args.out)
#define Q16 (((bf16*)args.out) + (size_t)T * D)
#define H16C ((bf16*)(ws + WS_Z + 128 * MiB))
#define HL (L == 0 ? P16 : Q16)
#define Zb ((bf16*)(ws + WS_Z))
#define AR ((bf16*)(ws + WS_AR))
#define RETS ((float*)(ws + WS_RETS))
#define VST ((bf16*)(ws + WS_VST))
#define VWT ((bf16*)(ws + WS_VWT))
#define HIDC ((bf16*)(ws + WS_HIDC))
#define KCMP ((bf16*)(ws + WS_KCMP))
#define VCMPT ((bf16*)(ws + WS_VCMPT))
#define POSB ((float*)(ws + WS_POSB))
#define BCNT ((int*)(ws + WS_BCNT))
#define META ((int*)(ws + WS_META))
#define TOKINFO ((float*)(ws + WS_TOKINFO))
#define TOKROW ((int*)(ws + WS_TOKROW))
#define ROWTOK ((int*)(ws + WS_ROWTOK))
#define RSTD ((float*)(ws + WS_RSTD))
#define SSA ((float*)(ws + WS_SSA))
#define SSB ((float*)(ws + WS_SSB))
#define HID8 ((unsigned char*)(ws + WS_HID))
#define H8 ((unsigned char*)(ws + WS_XN))
#define YP ((bf16*)(ws + WS_YP))
#define YP8 ((unsigned char*)(ws + WS_YP))
#define PP ((bf16*)(ws + WS_PP))
#define SIG8 ((unsigned char*)(ws + WS_PP))
#define PBALL ((bf16*)(ws + WS_PBALL))
    const LAS int* gtab = (const LAS int*)(F.lds + GTAB_OFF); LAS int* uinfo = (LAS int*)(F.lds + UINFO_OFF);
    LAS float* rtab = (LAS float*)(F.lds + RTAB_OFF);

    PH(0) {
        LAS float* scr = (LAS float*)(F.lds + F.wave * 16384);
        const int gw = F.bid * NWAVES + F.wave, NGW = F.G * NWAVES;
        for (int s = 0; s < NSEG; ++s) { const Seg g = seg_decode(args, s); const int nit = (g.K / 64) * (g.ncols / 32);
            for (int it = gw; it < nit; it += 2 * NGW) { f32x4 r0[8], r1[8]; const int it1 = it + NGW; transpose_load(g, it, F.lane, r0); if (it1 < nit) transpose_load(g, it1, F.lane, r1);
                transpose_store(g, scr, it, F.lane, r0); if (it1 < nit) transpose_store(g, scr, it1, F.lane, r1); } }
        __syncthreads();
        if (F.bid < 32) { const int hl = F.tid & 31, kg = F.tid >> 5, oi = F.bid * 32 + hl, lw = oi >> 8, hcol = oi & 255;
            const float* pos = args.in[I_CPOS] + (size_t)lw * 2048 + kg * 128; const float* w1 = args.in[I_CW1] + (size_t)lw * 2048 * 256 + (size_t)kg * 128 * 256 + hcol; float a = 0.f;
#pragma unroll 8
            for (int k = 0; k < 128; ++k) a += pos[k] * w1[(size_t)k * 256];
            LAS float* red = (LAS float*)F.lds; red[kg * 32 + hl] = a; __syncthreads();
            if (F.tid < 32) { float t = 0.f;
#pragma unroll
                for (int j = 0; j < 16; ++j) t += red[j * 32 + F.tid]; POSB[F.bid * 32 + F.tid] = t; }
            __syncthreads(); }
        norm_first(F, args.in[I_X], P16, RSTD);
        pb_convert(F, args.in[I_P], PBALL);
    }
    xcd_barrier(bar, F.wave0); RELAUNDER();

    for (int L = 0; L < 2; ++L) {
        unsigned char* wl = ws + WS_W + (size_t)L * WL_STRIDE;
        PH(1) {
          if (F8_IN1 && L == 1) { pg8::Gemm g{(const bf16*)H8, (const bf16*)(wl + WL_WIN), D / 2, D / 2, 128}; pg8::StaticOrder S; S.init(T / 256, ZP / 256, F.G, F.bid, (size_t)256 * D, (size_t)256 * D);
            pg8::EpiBf16<0, ST_MODE> E{Zb, ZP, nullptr, 0, 1.0f / (S8_H * S8_WU), IN_COLS}; fill_rtab<true>(F, S, rtab, SSA);
            pg8::gemm_phase<pg8::EpiBf16<0, ST_MODE>, pg8::StaticOrder, false, 1, true>(F.tid, F.lds, g, S, E, gtab, rtab); }
          else { pg8::Gemm g{HL, (const bf16*)(wl + WL_WIN), D, D, 128}; pg8::StaticOrder S; S.init(T / 256, ZP / 256, F.G, F.bid, (size_t)256 * D * 2, (size_t)256 * D * 2);
            pg8::EpiBf16<0, ST_MODE> E{Zb, ZP, nullptr, 0, 1.0f, IN_COLS};
            if (L == 0) fill_rtab<false>(F, S, rtab, RSTD); else fill_rtab<true>(F, S, rtab, SSA);
            pg8::gemm_phase<pg8::EpiBf16<0, ST_MODE>, pg8::StaticOrder, false, 1>(F.tid, F.lds, g, S, E, gtab, rtab); } }
        xcd_barrier(bar, F.wave0); RELAUNDER();
        PH(2) { pg8::Gemm g{Zb, (const bf16*)(wl + WL_CW1), 2048, 16 * ZP, ZP * 2}; pg8::CmpOrder S{F.G, F.bid};
          pg8::EpiBf16<2> E{HIDC, 256, POSB + L * 512, 5}; pg8::gemm_phase<pg8::EpiBf16<2>, pg8::CmpOrder, false>(F.tid, F.lds, g, S, E, gtab); }
        __syncthreads();
        PH(4) {
          if (F.G == 256) { const int w = F.bid - 64; ret_kv_units(F, Zb, RETS, w * 21 + (w < 64 ? w : 64), 1, w < 0 ? 0 : 21 + (w < 64 ? 1 : 0)); }
          else ret_kv_units(F, Zb, RETS, F.bid, F.G, (4096 - F.bid + F.G - 1) / F.G); }
        xcd_barrier(bar, F.wave0); RELAUNDER();
        PH(5) cmp_out(F, HIDC, args.in[I_CW2] + (size_t)L * 2 * 256 * 64, KCMP, VCMPT);
        PH(6) ret_scan(F, RETS);
        xcd_barrier(bar, F.wave0); RELAUNDER();
        {
          int hb = 0; unsigned* qctr = ctl + 8192 + 64 * L; LAS int* qslot = (LAS int*)(F.lds + MISC_OFF) + 16; int u = F.bid; const float* gnp = args.in[I_RETGN] + (size_t)L * 512;
          if (u < nsa::NQ) { nsa::Ctx X0; nsa::make_ctx(X0, F, Zb, KCMP, VCMPT, u); const int jm = (4 * X0.cur + 2) >> 6; nsa::dma_blk<0>(X0, jm, 0, F.lane); if (jm >= 1) nsa::dma_blk<0>(X0, jm - 1, 1, F.lane); }
#pragma nounroll
          while (u < nsa::NQ) u = F.G + nsa::unit(F, Zb, KCMP, VCMPT, AR, u, hb, qctr, qslot);
          __syncthreads();
          if (u < nsa::NQ + 4096) ret_out_dma(F, Zb, RETS, u - nsa::NQ, 0);
          int kb = 0;
#pragma nounroll
          while (u < nsa::NQ + 4096) { u = F.G + ret_out_unit(F, Zb, RETS, gnp, AR, u - nsa::NQ, kb, qctr, qslot); kb ^= 1; }
          __syncthreads(); }
        xcd_barrier(bar, F.wave0); RELAUNDER();
        PH(9) { pg8::Gemm g{AR, (const bf16*)(wl + WL_WOUT), D, D, 128}; pg8::StaticOrder S; S.init(T / 256, D / 256, F.G, F.bid, (size_t)256 * D * 2, (size_t)256 * D * 2);
          if (L == 0) { pg8::EpiRes16<(F8_DUP != 0)> E{P16, P16, SSA, H8, 1.0f}; pg8::gemm_phase<pg8::EpiRes16<(F8_DUP != 0)>, pg8::StaticOrder, false>(F.tid, F.lds, g, S, E, gtab); }
          else { pg8::EpiRes16<true> E{Q16, Q16, SSA, H8, 1.0f}; pg8::gemm_phase<pg8::EpiRes16<true>, pg8::StaticOrder, false>(F.tid, F.lds, g, S, E, gtab); } }
        xcd_barrier(bar, F.wave0); RELAUNDER();
        if (L == 0) {
            constexpr int FCH = 128;
            for (int ch = 0; ch < (T / 256) / FCH; ++ch) {
                PH(11) {
#if F8_DUP
                  pg8::Gemm g{(const bf16*)H8, (const bf16*)(ws + WS_WDENSE), D / 2, D / 2, 128}; pg8::StaticOrder S; S.init(FCH, 2 * DFF / 256, F.G, F.bid, (size_t)256 * D, (size_t)256 * D, ch * FCH); const float usc = 1.0f / (S8_H * S8_WU);
#else
                  pg8::Gemm g{P16, (const bf16*)(ws + WS_WDENSE), D, D, 128}; pg8::StaticOrder S; S.init(FCH, 2 * DFF / 256, F.G, F.bid, (size_t)256 * D * 2, (size_t)256 * D * 2, ch * FCH); const float usc = 1.0f;
#endif
                  fill_rtab<true>(F, S, rtab, SSA);
#if F8_DDN
                  pg8::EpiSwiGLU E{HID8, 0, usc}; pg8::gemm_phase<pg8::EpiSwiGLU, pg8::StaticOrder, false, 1, F8_DUP != 0>(F.tid, F.lds, g, S, E, gtab, rtab); }
#else
                  pg8::EpiSwiGLU16 E{(bf16*)HID8, 0, usc}; pg8::gemm_phase<pg8::EpiSwiGLU16, pg8::StaticOrder, false, 1, F8_DUP != 0>(F.tid, F.lds, g, S, E, gtab, rtab); }
#endif
                xcd_barrier(bar, F.wave0); RELAUNDER();
#if F8_DDN
                PH(12) { pg8::Gemm g{(const bf16*)HID8, (const bf16*)(ws + WS_WDENSE + 14 * MiB), DFF / 2, DFF / 2, 128}; pg8::StaticOrder S; S.init(FCH, D / 256, F.G, F.bid, (size_t)256 * DFF, (size_t)256 * DFF, ch * FCH);
                  pg8::EpiRes16<(F8_GATE != 0)> E{P16, P16, SSB, H8, 1.0f / (S8_HID * S8_WD)}; pg8::gemm_phase<pg8::EpiRes16<(F8_GATE != 0)>, pg8::StaticOrder, false, 0, true>(F.tid, F.lds, g, S, E, gtab); }
#else
                PH(12) { pg8::Gemm g{(const bf16*)HID8, (const bf16*)(ws + WS_WDENSE + 14 * MiB), DFF, DFF, 128}; pg8::StaticOrder S; S.init(FCH, D / 256, F.G, F.bid, (size_t)256 * DFF * 2, (size_t)256 * DFF * 2, ch * FCH);
                  pg8::EpiRes16<false> E{P16, P16, SSB, nullptr, 1.0f}; pg8::gemm_phase<pg8::EpiRes16<false>, pg8::StaticOrder, false>(F.tid, F.lds, g, S, E, gtab); }
#endif
                RELAUNDER();
            }
        } else {
            PH(14) norm_router(F, Q16, args.in[I_GFFN] + (size_t)L * D, args.in[I_ROUTER], TOKINFO, BCNT);
            xcd_barrier(bar, F.wave0); RELAUNDER();
            PH(15) moe_index(F, BCNT, TOKINFO, TOKROW, ROWTOK, META);
            xcd_barrier(bar, F.wave0); RELAUNDER();
            const int NP = __builtin_amdgcn_readfirstlane(__hip_atomic_load(META, __ATOMIC_RELAXED, __HIP_MEMORY_SCOPE_AGENT));
            const int rp = (NP + MOE_ROUNDS - 1) / MOE_ROUNDS, nrounds = rp > 0 ? (NP + rp - 1) / rp : 0;
            for (int rd = 0; rd < nrounds; ++rd) {
                const int pm0 = rd * rp, npan = (NP - pm0) < rp ? (NP - pm0) : rp;
                PH(16) { pg8::StaticOrder S0; S0.init(npan, 2 * DFF / 256, F.G, F.bid, 0, 0); int n = 0; pg8::Unit u;
                  int nrs = 0, lastpm = -1;
                  for (int i = 0; i < 32 && S0.next(i, u); ++i) { const int pm = pm0 + u.pm; const int ex = META[16 + pm];
                      if (F.tid == 0) { uinfo[4 * i] = pm; uinfo[4 * i + 1] = u.pn; uinfo[4 * i + 2] = ex; }
                      if (pm != lastpm) { if (nrs < 15 && F.tid == 0) uinfo[4 * nrs + 3] = pm; lastpm = pm; ++nrs; }
                      n = i + 1; }
                  __syncthreads();
                  { const int ns = nrs < 15 ? nrs : 15, r = F.tid & 255, s0 = F.tid >> 8; int toks[8];
#pragma unroll
                    for (int j = 0; j < 8; ++j) { const int sl = s0 + 2 * j; toks[j] = (sl < ns) ? ROWTOK[uinfo[4 * sl + 3] * 256 + r] : 0; }
#pragma unroll
                    for (int j = 0; j < 8; ++j) { const int sl = s0 + 2 * j; if (sl < ns) { ((LAS int*)(F.lds + GTAB_OFF))[sl * 256 + r] = toks[j]; rtab[sl * 256 + r] = rstd_from_ss(SSA, toks[j]); } } }
                  __syncthreads();
#if F8_MOE
                  pg8::Gemm g{(const bf16*)H8, (const bf16*)(ws + WS_WMOE), D / 2, D / 2, 128}; pg8::MoeOrder S{uinfo, n, pm0, 0, (size_t)256 * D, WE_STRIDE};
                  pg8::EpiSwiGLU E{HID8, pm0 * 256, 1.0f / (S8_H * S8_WU)}; pg8::gemm_phase<pg8::EpiSwiGLU, pg8::MoeOrder, true, 1, true>(F.tid, F.lds, g, S, E, gtab, rtab); }
#else
                  pg8::Gemm g{Q16, (const bf16*)(ws + WS_WMOE), D, D, 128}; pg8::MoeOrder S{uinfo, n, pm0, 0, (size_t)256 * D * 2, WE_STRIDE};
                  pg8::EpiSwiGLU16 E{(bf16*)HID8, pm0 * 256}; pg8::gemm_phase<pg8::EpiSwiGLU16, pg8::MoeOrder, true, 1>(F.tid, F.lds, g, S, E, gtab, rtab); }
#endif
                xcd_barrier(bar, F.wave0); RELAUNDER();
                PH(17) { pg8::StaticOrder S0; S0.init(npan, D / 256, F.G, F.bid, 0, 0); int n = 0; pg8::Unit u;
                  for (int i = 0; i < 32 && S0.next(i, u); ++i) { const int pm = pm0 + u.pm; const int ex = META[16 + pm];
                      if (F.tid == 0) { uinfo[4 * i] = pm; uinfo[4 * i + 1] = u.pn; uinfo[4 * i + 2] = ex; } n = i + 1; }
                  __syncthreads();
#if F8_MOE
                  pg8::Gemm g{(const bf16*)HID8, (const bf16*)(ws + WS_WMOE + WE_DOWN), DFF / 2, DFF / 2, 128}; pg8::MoeOrder S{uinfo, n, pm0, (size_t)256 * DFF, (size_t)256 * DFF, WE_STRIDE};
                  pg8::EpiOut8 E{YP8, D, S8_Y / (S8_HID * S8_WD)}; pg8::gemm_phase<pg8::EpiOut8, pg8::MoeOrder, false, 0, true>(F.tid, F.lds, g, S, E, gtab); }
#else
                  pg8::Gemm g{(const bf16*)HID8, (const bf16*)(ws + WS_WMOE + WE_DOWN), DFF, DFF, 128}; pg8::MoeOrder S{uinfo, n, pm0, (size_t)256 * DFF * 2, (size_t)256 * DFF * 2, WE_STRIDE};
                  pg8::EpiBf16<0> E{YP, D, nullptr, 0}; pg8::gemm_phase<pg8::EpiBf16<0>, pg8::MoeOrder, false>(F.tid, F.lds, g, S, E, gtab); }
#endif
                xcd_barrier(bar, F.wave0); RELAUNDER();
            }
            PH(18) moe_combine(F, Q16, H8, RSTD, YP8, TOKROW, TOKINFO);
        }
        xcd_barrier(bar, F.wave0); RELAUNDER();
        PH(20) {
#if F8_GATE
          pg8::Gemm g{(const bf16*)H8, (const bf16*)(wl + WL_PGATE), D / 2, D / 2, 128}; pg8::StaticOrder S; S.init(T / 256, D / 256, F.G, F.bid, (size_t)256 * D, (size_t)256 * D);
          if (L == 0) fill_rtab<true>(F, S, rtab, SSB); else fill_rtab<false>(F, S, rtab, RSTD);
          pg8::EpiSig8 E{SIG8, 1.0f / (S8_H * S8_WU)}; pg8::gemm_phase<pg8::EpiSig8, pg8::StaticOrder, false, 1, true>(F.tid, F.lds, g, S, E, gtab, rtab); }
#else
          pg8::Gemm g{HL, (const bf16*)(wl + WL_PGATE), D, D, 128}; pg8::StaticOrder S; S.init(T / 256, D / 256, F.G, F.bid, (size_t)256 * D * 2, (size_t)256 * D * 2);
          if (L == 0) fill_rtab<true>(F, S, rtab, SSB); else fill_rtab<false>(F, S, rtab, RSTD);
          pg8::EpiSig8 E{SIG8}; pg8::gemm_phase<pg8::EpiSig8, pg8::StaticOrder, false, 1>(F.tid, F.lds, g, S, E, gtab, rtab); }
#endif
        __syncthreads();
        PH(19) { pg8::Gemm g{PBALL + (size_t)L * T * PLE, (const bf16*)(wl + WL_PPROJ), PLE, PLE, 128}; pg8::StaticOrder S; S.init(T / 256, D / 256, F.G, F.bid, (size_t)256 * PLE * 2, (size_t)256 * PLE * 2);
          if (L == 0) { pg8::EpiPleApply<true> E{P16, SIG8, Q16, SSA}; pg8::gemm_phase<pg8::EpiPleApply<true>, pg8::StaticOrder, false>(F.tid, F.lds, g, S, E, gtab); }
          else { pg8::EpiPleApply<false> E{Q16, SIG8, H16C, nullptr}; pg8::gemm_phase<pg8::EpiPleApply<false>, pg8::StaticOrder, false>(F.tid, F.lds, g, S, E, gtab); } }
        xcd_barrier(bar, F.wave0); RELAUNDER();
    }
    PH(22) norm_final(F, H16C, args.in[I_GFINAL], args.out);
}

extern "C" void kernel_launch(void* const* d_in, const int* in_sizes, int n_in, void* d_out, int out_size, void* d_ws, size_t ws_size, hipStream_t stream) {
    static int grid = 0;
    if (grid == 0) {
        if (n_in != 21 || out_size != T * D || ws_size < WS_END) { fprintf(stderr, "kernel_launch: unexpected shapes (n_in %d out %d ws %zu)\n", n_in, out_size, ws_size); grid = -1; return; }
        int dev = 0, cus = 0, per_cu = 0;
        if (hipGetDevice(&dev) != hipSuccess || hipDeviceGetAttribute(&cus, hipDeviceAttributeMultiprocessorCount, dev) != hipSuccess) { grid = -1; return; }
        if (hipFuncSetAttribute((const void*)hybrid_fwd, hipFuncAttributeMaxDynamicSharedMemorySize, LDS_BYTES) != hipSuccess) { fprintf(stderr, "kernel_launch: hipFuncSetAttribute failed\n"); grid = -1; return; }
        if (hipOccupancyMaxActiveBlocksPerMultiprocessor(&per_cu, (const void*)hybrid_fwd, NTHR, LDS_BYTES) != hipSuccess || per_cu < 1) fprintf(stderr, "kernel_launch: occupancy query reports %d\n", per_cu);
        (void)hipGetLastError();
        grid = cus;
    }
    if (grid < 0) return;
    if (hipMemsetAsync((char*)d_ws + WS_CTL, 0, CTL_ZERO_BYTES, stream) != hipSuccess) return;
    Args a{};
    for (int i = 0; i < 21; ++i) a.in[i] = (const float*)d_in[i];
    a.out = (float*)d_out; a.ws = (unsigned char*)d_ws;
    hipLaunchKernelGGL(hybrid_fwd, dim3(grid), dim3(NTHR), LDS_BYTES, stream, a);
}
```

```cpp
#include <hip/hip_runtime.h>
#include <cstdio>
#include <cstdint>

#define DI __device__ __forceinline__
#define LAS __attribute__((address_space(3)))
#define GAS __attribute__((address_space(1)))
typedef unsigned short bf16;
typedef short bf16x8 __attribute__((ext_vector_type(8)));
typedef float f32x4 __attribute__((ext_vector_type(4)));
typedef float f32x2 __attribute__((ext_vector_type(2)));
typedef unsigned u32x4 __attribute__((ext_vector_type(4)));
typedef unsigned u32x2 __attribute__((ext_vector_type(2)));
typedef __bf16 bf16x2_t __attribute__((ext_vector_type(2)));

constexpr int NB = 8, SEQ = 8192, T = NB * SEQ, D = 1024, DFF = 3584, NE = 8, PLE = 256;
constexpr int IN_COLS = 3352, ZP = 3584;
constexpr int Z_QN = 0, Z_KC = 512, Z_VC = 640, Z_KS = 768, Z_VS = 896, Z_KW = 1024, Z_VW = 1152, Z_QR = 1280, Z_KR = 1792, Z_VR = 2304, Z_GR = 2816, Z_GL = 3328;
constexpr float EPS = 1e-6f, LOG2E = 1.4426950408889634f;
constexpr int MAXROWS = 2 * T + NE * 256;
constexpr int MOE_ROUNDS = 3, RPANELS_MAX = 174;

constexpr size_t MiB = 1u << 20;
constexpr size_t WS_CTL = 0, CTL_ZERO_BYTES = 1 * MiB;
constexpr size_t WS_POSB = 1 * MiB;
constexpr size_t WS_BCNT = 1 * MiB + 65536;
constexpr size_t WS_META = 1 * MiB + 131072;
constexpr size_t WS_TOKINFO = 2 * MiB;
constexpr size_t WS_TOKROW = 3 * MiB;
constexpr size_t WS_ROWTOK = 4 * MiB;
constexpr size_t WS_RSTD = 5 * MiB;
constexpr size_t WS_SSA = 996 * MiB, WS_SSB = 1000 * MiB;
constexpr size_t WS_PBALL = 932 * MiB;
constexpr size_t WS_W = 6 * MiB;
constexpr size_t WL_STRIDE = 14 * MiB, WL_WIN = 0, WL_WOUT = 7 * MiB, WL_PGATE = 9 * MiB, WL_PPROJ = 11 * MiB, WL_CW1 = 11 * MiB + 512 * 1024;
constexpr size_t WS_WDENSE = WS_W + 2 * WL_STRIDE;
constexpr size_t WS_WMOE = WS_WDENSE + 22 * MiB;
constexpr size_t WE_STRIDE = 21 * MiB, WE_DOWN = 14 * MiB;
constexpr size_t WS_XN = 224 * MiB;
constexpr size_t WS_RETS = WS_XN, WS_VST = WS_XN + 64 * MiB, WS_VWT = WS_XN + 80 * MiB, WS_HIDC = WS_XN + 96 * MiB, WS_KCMP = WS_XN + 104 * MiB, WS_VCMPT = WS_XN + 105 * MiB;
constexpr size_t WS_Z = 352 * MiB;
constexpr size_t WS_HID = WS_Z;
constexpr size_t WS_YP = WS_Z + 306 * MiB;
constexpr size_t WS_PP = WS_Z;
constexpr size_t WS_AR = 800 * MiB;
constexpr size_t WS_END = 1004 * MiB;
static_assert(WS_YP + (size_t)MAXROWS * D * 2 <= WS_PBALL && (size_t)RPANELS_MAX * 256 * DFF * 2 <= 306 * MiB && 3 * RPANELS_MAX >= MAXROWS / 256, "MoE buffers fit");
static_assert(WS_WMOE + NE * WE_STRIDE <= WS_XN, "weights fit");

constexpr int RING_BYTES = 131072;
constexpr int GTAB_OFF = RING_BYTES;
constexpr int RTAB_OFF = GTAB_OFF + 16384;
constexpr int UINFO_OFF = RTAB_OFF + 15360;
constexpr int MISC_OFF = UINFO_OFF + 512;
constexpr int LDS_BYTES = MISC_OFF + 128;
static_assert(LDS_BYTES <= 163840, "LDS");
constexpr int NWAVES = 8, NTHR = 512;
#ifndef PHMASK
#define PHMASK 0xFFFFFFFFu
#endif
#ifndef REPMASK
#define REPMASK 0u
#endif
#define PH(k) if constexpr (((PHMASK) >> (k)) & 1u) for (int rep_ = 0; rep_ < ((((REPMASK) >> (k)) & 1u) ? 2 : 1); ++rep_)

DI unsigned pk(float lo, float hi) { f32x2 v = {lo, hi}; bf16x2_t b = __builtin_convertvector(v, bf16x2_t); return __builtin_bit_cast(unsigned, b); }
DI float bflo(unsigned u) { return __uint_as_float(u << 16); }
DI float bfhi(unsigned u) { return __uint_as_float(u & 0xffff0000u); }
DI float bf2f(bf16 h) { return __uint_as_float(((unsigned)h) << 16); }
typedef int i32x8 __attribute__((ext_vector_type(8)));
typedef int i32x4_t __attribute__((ext_vector_type(4)));
DI unsigned pk8(float a, float b, float c, float d) {
    a = __builtin_fminf(__builtin_fmaxf(a, -448.f), 448.f); b = __builtin_fminf(__builtin_fmaxf(b, -448.f), 448.f); c = __builtin_fminf(__builtin_fmaxf(c, -448.f), 448.f); d = __builtin_fminf(__builtin_fmaxf(d, -448.f), 448.f);
    int w = 0; w = __builtin_amdgcn_cvt_pk_fp8_f32(a, b, w, false); w = __builtin_amdgcn_cvt_pk_fp8_f32(c, d, w, true); return (unsigned)w;
}
#ifndef F8_DENSE
#define F8_DENSE 0
#endif
#ifndef F8_IN1
#define F8_IN1 0
#endif
#ifndef F8_DUP
#define F8_DUP 0
#endif
#ifndef F8_DDN
#define F8_DDN 1
#endif
#ifndef F8_GATE
#define F8_GATE 1
#endif
#ifndef F8_MOE
#define F8_MOE 1
#endif
constexpr float S8_H = 8.f, S8_WU = 32.f, S8_HID = 8.f, S8_WD = 64.f, S8_Y = 16.f;
DI float wave_sum(float v) {
#pragma unroll
    for (int o = 1; o < 64; o <<= 1) v += __shfl_xor(v, o);
    return v;
}
DI float fexp2(float x) { return __builtin_amdgcn_exp2f(x); }
DI float frcp(float x) { return __builtin_amdgcn_rcpf(x); }
DI float sigmoidf_(float x) { return frcp(1.f + fexp2(-x * LOG2E)); }
DI float siluf_(float x) { return x * sigmoidf_(x); }
DI bf16x8 mk8(unsigned a, unsigned b, unsigned c, unsigned d) { u32x4 w = {a, b, c, d}; return __builtin_bit_cast(bf16x8, w); }
#define MFMA16(a, b, c) __builtin_amdgcn_mfma_f32_16x16x32_bf16((a), (b), (c), 0, 0, 0)
typedef short s16x4 __attribute__((ext_vector_type(4)));
DI s16x4 ldtr(const LAS unsigned char* p) { return __builtin_bit_cast(s16x4, __builtin_amdgcn_ds_read_tr16_b64_v4i16((LAS s16x4*)p)); }
DI bf16x8 tr_frag(const LAS unsigned char* img, int kgrp, int ct, int fr, int fq) {
    const LAS unsigned char* p = img + (4 * fq + (fr >> 2)) * 128 + kgrp * 4096 + ((ct ^ ((2 * (fq & 1) + (fr >> 3)) & 3)) << 5) + ((fr & 3) << 3);
    const s16x4 lo = ldtr(p), hi = ldtr(p + 2048); return (bf16x8){lo[0], lo[1], lo[2], lo[3], hi[0], hi[1], hi[2], hi[3]};
}
DI int tr_chunk(int row, int ch) { return ch ^ (2 * ((row >> 1) & 3)); }
DI void gl16(const void* gsrc, unsigned lds_dst) { unsigned keep;
    asm volatile("s_mov_b32 %0, m0\n\ts_mov_b32 m0, %2\n\ts_nop 0\n\tglobal_load_lds_dwordx4 %1, off\n\ts_mov_b32 m0, %0" : "=&s"(keep) : "v"(gsrc), "s"(lds_dst) : "memory"); }

namespace pg8 {
constexpr int BM = 256, BK = 64, HALF = 128, HTB = HALF * BK * 2, STAGE_BYTES = 8 * HTB, NXCD = 8, WGM = 8;
__host__ __device__ __forceinline__ int lds_byte(int r, int c) { const int st = (r >> 4) * 2 + (c >> 5), rr = r & 15, cc = c & 31, ob = rr * 64 + cc * 2; return st * 1024 + (ob ^ (((ob >> 9) & 1) << 5)); }
__host__ __device__ __forceinline__ void stage_rc(int b, int& R, int& C) { const int st = b / 1024, sb = b % 1024, swz = sb ^ (((sb >> 9) & 1) << 5); R = (st >> 1) * 16 + swz / 64; C = (st & 1) * 32 + (swz % 64) / 2; }
__host__ __device__ __forceinline__ int perm32(int rho) { const int n = rho >> 4, i = rho & 15; return 8 * (i >> 2) + 4 * n + (i & 3); }

struct Unit { int pm, pn, ex; };
struct Gemm { const bf16* A; const bf16* Bt; int K; int lda; int kstepA; };

struct StaticOrder {
    int nM, nN, nwg, G, c, pm0; size_t tA, tB;
    DI void init(int nM_, int nN_, int G_, int c_, size_t tA_, size_t tB_, int pm0_ = 0) { nM = nM_; nN = nN_; nwg = nM * nN; G = G_; c = c_; tA = tA_; tB = tB_; pm0 = pm0_; }
    DI bool next(int i, Unit& u) const {
        const long L = (long)i * G + c; if (L >= nwg) return false;
        int wgid = (int)L; { const int q = nwg / NXCD, r = nwg % NXCD, xcd = wgid % NXCD, off = wgid / NXCD; wgid = (xcd < r ? xcd * (q + 1) : r * (q + 1) + (xcd - r) * q) + off; }
        const int nig = WGM * nN, gid = wgid / nig, fm = gid * WGM, gsz = (nM - fm) < WGM ? (nM - fm) : WGM;
        u.pm = pm0 + fm + ((wgid % nig) % gsz); u.pn = (wgid % nig) / gsz; u.ex = 0; return true;
    }
    DI size_t a_off(const Unit& u) const { return (size_t)u.pm * tA; }
    DI size_t b_off(const Unit& u) const { return (size_t)u.pn * tB; }
};
struct PanelOrder {
    int nM, G, c; size_t tA, tB;
    DI bool next(int i, Unit& u) const { const int pm = c + (i >> 2) * G; if (pm >= nM) return false; u.pm = pm; u.pn = i & 3; u.ex = 0; return true; }
    DI size_t a_off(const Unit& u) const { return (size_t)u.pm * tA; }
    DI size_t b_off(const Unit& u) const { return (size_t)u.pn * tB; }
};
struct CmpOrder {
    int G, c;
    DI bool next(int i, Unit& u) const { const int L = i * G + c; if (L >= 64) return false; u.pm = L; u.pn = 0; u.ex = 0; return true; }
    DI size_t a_off(const Unit& u) const { const int combo = u.pm >> 4, which = combo >> 1, g = combo & 1; return ((size_t)(u.pm & 15) * 256 * 16 * ZP + (which ? Z_VC : Z_KC) + g * 64) * 2; }
    DI size_t b_off(const Unit& u) const { return (size_t)(u.pm >> 5) * 256 * 2048 * 2; }
};
struct MoeOrder {
    const LAS int* info; int n; int pm0; size_t tA, tB, eB;
    DI bool next(int i, Unit& u) const { if (i >= n) return false; u.pm = info[4 * i]; u.pn = info[4 * i + 1]; u.ex = info[4 * i + 2]; return true; }
    DI size_t a_off(const Unit& u) const { return (size_t)(u.pm - pm0) * tA; }
    DI size_t b_off(const Unit& u) const { return (size_t)u.ex * eB + (size_t)u.pn * tB; }
};

#ifndef ST_MODE
#define ST_MODE 1
#endif
template <int MODE> DI void st16(void* p, const u32x4& w) {
    if constexpr (MODE == 2) asm volatile("global_store_dwordx4 %0, %1, off sc1\n\ts_nop 1" :: "v"(p), "v"(w) : "memory");
    else if constexpr (MODE == 1) asm volatile("global_store_dwordx4 %0, %1, off nt\n\ts_nop 1" :: "v"(p), "v"(w) : "memory");
    else *(u32x4*)p = w;
}
template <int MODE> DI void st8(void* p, const u32x2& w) {
    if constexpr (MODE == 2) asm volatile("global_store_dwordx2 %0, %1, off sc1\n\ts_nop 1" :: "v"(p), "v"(w) : "memory");
    else *(u32x2*)p = w;
}
template <int MODE> DI void st16o(void* base, unsigned off, const u32x4& w) {
    if constexpr (MODE == 2) asm volatile("global_store_dwordx4 %0, %1, %2 sc1\n\ts_nop 1" :: "v"(off), "v"(w), "s"(base) : "memory");
    else *(u32x4*)((char*)base + off) = w;
}
template <int MODE> DI void st8o(void* base, unsigned off, const u32x2& w) {
    if constexpr (MODE == 2) asm volatile("global_store_dwordx2 %0, %1, %2 sc1\n\ts_nop 1" :: "v"(off), "v"(w), "s"(base) : "memory");
    else *(u32x2*)((char*)base + off) = w;
}
constexpr int ST_OUT = (ST_MODE == 2) ? 2 : 0;
DI u32x4 pair16(const u32x2& wa, const u32x2& wb) {
    const u32x2 s0 = __builtin_amdgcn_permlane16_swap(wa.x, wb.x, false, false), s1 = __builtin_amdgcn_permlane16_swap(wa.y, wb.y, false, false);
    return (u32x4){s0.x, s1.x, s0.y, s1.y};
}
template <int ACT  , int SM = 0  > struct EpiBf16 {
    static constexpr bool PERM = true;
    bf16* O; int ldc; const float* bias; int bias_shift; float osc = 1.0f; int ncv = 1 << 30;
    DI void operator()(const f32x4 (&acc)[2][2][4][2], const Unit& u, int wr, int wc, int fr, int fq, const float (&rs)[2][4]) const {
        const int row0 = u.pm * BM + wr * 64 + fr, col0 = u.pn * BM + wc * 32 + 8 * fq;
        f32x4 bv[2][2];
#pragma unroll
        for (int bj = 0; bj < 2; ++bj)
#pragma unroll
            for (int n = 0; n < 2; ++n) bv[bj][n] = (ACT == 2) ? *(const f32x4*)(bias + (size_t)(u.pm >> bias_shift) * 256 + col0 + bj * HALF + 4 * n) : (f32x4){0.f, 0.f, 0.f, 0.f};
#pragma unroll
        for (int ai = 0; ai < 2; ++ai)
#pragma unroll
            for (int m = 0; m < 4; ++m) { bf16* rowp = O + (size_t)(row0 + ai * HALF + m * 16) * ldc + col0;
#pragma unroll
                for (int bj = 0; bj < 2; ++bj) { const float r_ = rs[ai][m] * osc; f32x4 v0 = acc[ai][bj][m][0] * r_ + bv[bj][0], v1 = acc[ai][bj][m][1] * r_ + bv[bj][1];
                    if (ACT == 2) {
#pragma unroll
                        for (int e = 0; e < 4; ++e) { float x = v0[e]; float uu = 0.7978845608f * (x + 0.044715f * x * x * x); v0[e] = x * frcp(1.f + fexp2(-2.f * LOG2E * uu));
                                                      x = v1[e]; uu = 0.7978845608f * (x + 0.044715f * x * x * x); v1[e] = x * frcp(1.f + fexp2(-2.f * LOG2E * uu)); } }
                    u32x4 w; w.x = pk(v0[0], v0[1]); w.y = pk(v0[2], v0[3]); w.z = pk(v1[0], v1[1]); w.w = pk(v1[2], v1[3]);
                    if (col0 + bj * HALF < ncv) st16<SM>(rowp + bj * HALF, w); } }
    }
};
struct EpiOut8 {
    static constexpr bool PERM = true;
    unsigned char* O; int ldc; float osc;
    DI void operator()(const f32x4 (&acc)[2][2][4][2], const Unit& u, int wr, int wc, int fr, int fq, const float (&rs)[2][4]) const {
        const int row0 = u.pm * BM + wr * 64 + fr, col0 = u.pn * BM + wc * 32 + 8 * (fq & ~1);
#pragma unroll
        for (int ai = 0; ai < 2; ++ai)
#pragma unroll
            for (int bj = 0; bj < 2; ++bj) { u32x2 w[4];
#pragma unroll
                for (int m = 0; m < 4; ++m) { const f32x4 v0 = acc[ai][bj][m][0] * osc, v1 = acc[ai][bj][m][1] * osc; w[m].x = pk8(v0[0], v0[1], v0[2], v0[3]); w[m].y = pk8(v1[0], v1[1], v1[2], v1[3]); }
#pragma unroll
                for (int mp = 0; mp < 2; ++mp) { const u32x4 o16 = pair16(w[2 * mp], w[2 * mp + 1]);
                    *(u32x4*)(O + (size_t)(row0 + ai * HALF + (2 * mp + (fq & 1)) * 16) * ldc + col0 + bj * HALF) = o16; } }
    }
};
template <bool W8> struct EpiRes16 {
    static constexpr bool PERM = true;
    const bf16* base; bf16* out; float* ss; unsigned char* h8; float sc;
    DI void operator()(const f32x4 (&acc)[2][2][4][2], const Unit& u, int wr, int wc, int fr, int fq, const float (&rs)[2][4]) const {
        const int row0 = u.pm * BM + wr * 64 + fr, col0 = u.pn * BM + wc * 32 + 8 * fq;
        const unsigned o0 = ((unsigned)row0 * D + col0) * 2u;
#pragma unroll
        for (int ai = 0; ai < 2; ++ai) {
            u32x4 bb[4][2];
#pragma unroll
            for (int m = 0; m < 4; ++m)
#pragma unroll
                for (int bj = 0; bj < 2; ++bj) bb[m][bj] = *(const u32x4*)((const char*)base + (o0 + (unsigned)(((ai * HALF + m * 16) * D + bj * HALF) * 2)));
            float sqv[4]; u32x2 w8[4][2];
#pragma unroll
            for (int m = 0; m < 4; ++m) { float sq = 0.f;
#pragma unroll
                for (int bj = 0; bj < 2; ++bj) { const u32x4 b = bb[m][bj]; const f32x4 a0 = acc[ai][bj][m][0] * sc, a1 = acc[ai][bj][m][1] * sc;
                    const float h0 = bflo(b.x) + a0[0], h1 = bfhi(b.x) + a0[1], h2 = bflo(b.y) + a0[2], h3 = bfhi(b.y) + a0[3], h4 = bflo(b.z) + a1[0], h5 = bfhi(b.z) + a1[1], h6 = bflo(b.w) + a1[2], h7 = bfhi(b.w) + a1[3];
                    sq += ((h0 * h0 + h1 * h1) + (h2 * h2 + h3 * h3)) + ((h4 * h4 + h5 * h5) + (h6 * h6 + h7 * h7));
                    const unsigned o2 = o0 + (unsigned)(((ai * HALF + m * 16) * D + bj * HALF) * 2);
                    u32x4 w; w.x = pk(h0, h1); w.y = pk(h2, h3); w.z = pk(h4, h5); w.w = pk(h6, h7); st16o<ST_OUT>(out, o2, w);
                    if constexpr (W8) { w8[m][bj].x = pk8(h0 * S8_H, h1 * S8_H, h2 * S8_H, h3 * S8_H); w8[m][bj].y = pk8(h4 * S8_H, h5 * S8_H, h6 * S8_H, h7 * S8_H); } }
                sq += __shfl_xor(sq, 16); sq += __shfl_xor(sq, 32); sqv[m] = sq; }
            { const float sqm = fq == 0 ? sqv[0] : fq == 1 ? sqv[1] : fq == 2 ? sqv[2] : sqv[3]; ss[(size_t)(row0 + ai * HALF + fq * 16) * 16 + 4 * u.pn + wc] = sqm; }
            if constexpr (W8) {
#pragma unroll
                for (int mp = 0; mp < 2; ++mp)
#pragma unroll
                    for (int bj = 0; bj < 2; ++bj) { const u32x4 o16 = pair16(w8[2 * mp][bj], w8[2 * mp + 1][bj]);
                        *(u32x4*)(h8 + (size_t)(row0 + ai * HALF + (2 * mp + (fq & 1)) * 16) * D + u.pn * BM + wc * 32 + 8 * (fq & ~1) + bj * HALF) = o16; } }
        }
    }
};
struct EpiSwiGLU16 {
    static constexpr bool PERM = true;
    bf16* O; int rowsub; float sc = 1.0f;
    DI void operator()(const f32x4 (&acc)[2][2][4][2], const Unit& u, int wr, int wc, int fr, int fq, const float (&rs)[2][4]) const {
        const int row0 = u.pm * BM - rowsub + wr * 64 + fr, col0 = u.pn * HALF + wc * 32 + 8 * fq;
#pragma unroll
        for (int ai = 0; ai < 2; ++ai)
#pragma unroll
            for (int m = 0; m < 4; ++m) { f32x4 h0, h1;
#pragma unroll
                for (int e = 0; e < 4; ++e) { const float r_ = rs[ai][m] * sc; h0[e] = siluf_(acc[ai][0][m][0][e] * r_) * (acc[ai][1][m][0][e] * r_); h1[e] = siluf_(acc[ai][0][m][1][e] * r_) * (acc[ai][1][m][1][e] * r_); }
                u32x4 w; w.x = pk(h0[0], h0[1]); w.y = pk(h0[2], h0[3]); w.z = pk(h1[0], h1[1]); w.w = pk(h1[2], h1[3]);
                st16<ST_OUT>(O + (size_t)(row0 + ai * HALF + m * 16) * DFF + col0, w); }
    }
};
struct EpiSwiGLU {
    static constexpr bool PERM = true;
    unsigned char* O; int rowsub; float sc;
    DI void operator()(const f32x4 (&acc)[2][2][4][2], const Unit& u, int wr, int wc, int fr, int fq, const float (&rs)[2][4]) const {
        const int row0 = u.pm * BM - rowsub + wr * 64 + fr, col0 = u.pn * HALF + wc * 32 + 8 * (fq & ~1);
#pragma unroll
        for (int ai = 0; ai < 2; ++ai) { u32x2 w[4];
#pragma unroll
            for (int m = 0; m < 4; ++m) { f32x4 h0, h1; const float r_ = rs[ai][m] * sc, ru = r_ * S8_HID;
#pragma unroll
                for (int n = 0; n < 2; ++n)
#pragma unroll
                    for (int e = 0; e < 4; e += 2) {
                        const f32x2 g = (f32x2){acc[ai][0][m][n][e], acc[ai][0][m][n][e + 1]} * r_, u = (f32x2){acc[ai][1][m][n][e], acc[ai][1][m][n][e + 1]} * ru;
                        const f32x2 t = g * (-LOG2E); const f32x2 d = (f32x2){fexp2(t[0]), fexp2(t[1])} + 1.0f; const f32x2 h = g * (f32x2){frcp(d[0]), frcp(d[1])} * u;
                        if (n == 0) { h0[e] = h[0]; h0[e + 1] = h[1]; } else { h1[e] = h[0]; h1[e + 1] = h[1]; } }
                w[m].x = pk8(h0[0], h0[1], h0[2], h0[3]); w[m].y = pk8(h1[0], h1[1], h1[2], h1[3]); }
#pragma unroll
            for (int mp = 0; mp < 2; ++mp) { const u32x4 o16 = pair16(w[2 * mp], w[2 * mp + 1]);
                *(u32x4*)(O + (size_t)(row0 + ai * HALF + (2 * mp + (fq & 1)) * 16) * DFF + col0) = o16; } }
    }
};
struct EpiSig8 {
    static constexpr bool PERM = true;
    unsigned char* O; float osc = 1.0f;
    DI void operator()(const f32x4 (&acc)[2][2][4][2], const Unit& u, int wr, int wc, int fr, int fq, const float (&rs)[2][4]) const {
        const int row0 = u.pm * BM + wr * 64 + fr, col0 = u.pn * BM + wc * 32 + 8 * (fq & ~1);
#pragma unroll
        for (int ai = 0; ai < 2; ++ai)
#pragma unroll
            for (int bj = 0; bj < 2; ++bj) { u32x2 w[4];
#pragma unroll
                for (int m = 0; m < 4; ++m) { const float rt = rs[ai][m] * osc * (-LOG2E); unsigned p[2] = {0u, 0u};
#pragma unroll
                    for (int n = 0; n < 2; ++n)
#pragma unroll
                        for (int e = 0; e < 4; e += 2) { const f32x2 t = (f32x2){acc[ai][bj][m][n][e], acc[ai][bj][m][n][e + 1]} * rt; const f32x2 d = (f32x2){fexp2(t[0]), fexp2(t[1])} + 1.0f;
                            const f32x2 sg = (f32x2){frcp(d[0]), frcp(d[1])} * 255.0f + 0.5f;
                            p[n] = __builtin_amdgcn_cvt_pk_u8_f32(sg[0], e, p[n]); p[n] = __builtin_amdgcn_cvt_pk_u8_f32(sg[1], e + 1, p[n]); }
                    w[m].x = p[0]; w[m].y = p[1]; }
#pragma unroll
                for (int mp = 0; mp < 2; ++mp) *(u32x4*)(O + (size_t)(row0 + ai * HALF + (2 * mp + (fq & 1)) * 16) * D + col0 + bj * HALF) = pair16(w[2 * mp], w[2 * mp + 1]); }
    }
};
template <bool NORM> struct EpiPleApply {
    static constexpr bool PERM = true;
    const bf16* base; const unsigned char* SG; bf16* out; float* ss;
    DI void operator()(const f32x4 (&acc)[2][2][4][2], const Unit& u, int wr, int wc, int fr, int fq, const float (&rs)[2][4]) const {
        const int row0 = u.pm * BM + wr * 64 + fr, col0 = u.pn * BM + wc * 32 + 8 * fq;
        const unsigned o0 = ((unsigned)row0 * D + col0) * 2u;
#pragma unroll
        for (int ai = 0; ai < 2; ++ai) {
            u32x4 bb[4][2]; u32x2 sg[4][2];
#pragma unroll
            for (int m = 0; m < 4; ++m)
#pragma unroll
                for (int bj = 0; bj < 2; ++bj) bb[m][bj] = *(const u32x4*)((const char*)base + (o0 + (unsigned)(((ai * HALF + m * 16) * D + bj * HALF) * 2)));
#pragma unroll
            for (int mp = 0; mp < 2; ++mp)
#pragma unroll
                for (int bj = 0; bj < 2; ++bj) { const u32x4 L = *(const u32x4*)(SG + (size_t)(row0 + ai * HALF + (2 * mp + (fq & 1)) * 16) * D + u.pn * BM + wc * 32 + 8 * (fq & ~1) + bj * HALF);
                    const u32x2 s0 = __builtin_amdgcn_permlane16_swap(L.x, L.z, false, false), s1 = __builtin_amdgcn_permlane16_swap(L.y, L.w, false, false);
                    sg[2 * mp][bj] = (u32x2){s0.x, s1.x}; sg[2 * mp + 1][bj] = (u32x2){s0.y, s1.y}; }
            float sqv[4];
#pragma unroll
            for (int m = 0; m < 4; ++m) { f32x2 sq2 = {0.f, 0.f};
#pragma unroll
                for (int bj = 0; bj < 2; ++bj) { const u32x4 b = bb[m][bj]; const u32x2 g8 = sg[m][bj]; const f32x4 a0 = acc[ai][bj][m][0], a1 = acc[ai][bj][m][1];
                    f32x2 hh[4];
#pragma unroll
                    for (int j = 0; j < 4; ++j) { const unsigned bw = j == 0 ? b.x : j == 1 ? b.y : j == 2 ? b.z : b.w; const unsigned gw = (j < 2) ? g8.x : g8.y; const int sh = 16 * (j & 1);
                        const f32x2 a2 = (j < 2) ? (f32x2){a0[2 * j], a0[2 * j + 1]} : (f32x2){a1[2 * j - 4], a1[2 * j - 3]};
                        const f32x2 sv = (f32x2){(float)((gw >> sh) & 0xffu), (float)((gw >> (sh + 8)) & 0xffu)} * (1.0f / 255.0f);
                        hh[j] = (f32x2){bflo(bw), bfhi(bw)} + a2 * sv;
                        if (NORM) sq2 = sq2 + hh[j] * hh[j]; }
                    const unsigned o2 = o0 + (unsigned)(((ai * HALF + m * 16) * D + bj * HALF) * 2);
                    u32x4 w; w.x = pk(hh[0][0], hh[0][1]); w.y = pk(hh[1][0], hh[1][1]); w.z = pk(hh[2][0], hh[2][1]); w.w = pk(hh[3][0], hh[3][1]); st16o<ST_OUT>(out, o2, w); }
                if (NORM) { float sq = sq2[0] + sq2[1]; sq += __shfl_xor(sq, 16); sq += __shfl_xor(sq, 32); sqv[m] = sq; } }
            if (NORM) { const float sqm = fq == 0 ? sqv[0] : fq == 1 ? sqv[1] : fq == 2 ? sqv[2] : sqv[3]; ss[(size_t)(row0 + ai * HALF + fq * 16) * 16 + 4 * u.pn + wc] = sqm; }
        }
    }
};
template <bool NORM> struct EpiPleGate {
    static constexpr bool PERM = true;
    const bf16* base; const bf16* PP; bf16* out; float* ss; unsigned char* h8 = nullptr;
    DI void operator()(const f32x4 (&acc)[2][2][4][2], const Unit& u, int wr, int wc, int fr, int fq, const float (&rs)[2][4]) const {
        const int row0 = u.pm * BM + wr * 64 + fr, col0 = u.pn * BM + wc * 32 + 8 * fq;
        const unsigned o0 = ((unsigned)row0 * D + col0) * 2u;
#pragma unroll
        for (int ai = 0; ai < 2; ++ai) {
            u32x4 bb[4][2], pq[4][2];
#pragma unroll
            for (int m = 0; m < 4; ++m)
#pragma unroll
                for (int bj = 0; bj < 2; ++bj) { const unsigned o2 = o0 + (unsigned)(((ai * HALF + m * 16) * D + bj * HALF) * 2); bb[m][bj] = *(const u32x4*)((const char*)base + o2); pq[m][bj] = *(const u32x4*)((const char*)PP + o2); }
            float sqv[4];
#pragma unroll
            for (int m = 0; m < 4; ++m) { float sq = 0.f; const float r_ = rs[ai][m];
#pragma unroll
                for (int bj = 0; bj < 2; ++bj) { const unsigned o2 = o0 + (unsigned)(((ai * HALF + m * 16) * D + bj * HALF) * 2); const u32x4 b = bb[m][bj], pp = pq[m][bj]; const f32x4 a0 = acc[ai][bj][m][0], a1 = acc[ai][bj][m][1];
                    const float h0 = bflo(b.x) + bflo(pp.x) * sigmoidf_(a0[0] * r_), h1 = bfhi(b.x) + bfhi(pp.x) * sigmoidf_(a0[1] * r_), h2 = bflo(b.y) + bflo(pp.y) * sigmoidf_(a0[2] * r_), h3 = bfhi(b.y) + bfhi(pp.y) * sigmoidf_(a0[3] * r_);
                    const float h4 = bflo(b.z) + bflo(pp.z) * sigmoidf_(a1[0] * r_), h5 = bfhi(b.z) + bfhi(pp.z) * sigmoidf_(a1[1] * r_), h6 = bflo(b.w) + bflo(pp.w) * sigmoidf_(a1[2] * r_), h7 = bfhi(b.w) + bfhi(pp.w) * sigmoidf_(a1[3] * r_);
                    if (NORM) sq += ((h0 * h0 + h1 * h1) + (h2 * h2 + h3 * h3)) + ((h4 * h4 + h5 * h5) + (h6 * h6 + h7 * h7));
                    u32x4 w; w.x = pk(h0, h1); w.y = pk(h2, h3); w.z = pk(h4, h5); w.w = pk(h6, h7); st16o<ST_OUT>(out, o2, w);
                    if constexpr (NORM && F8_IN1) { u32x2 w8; w8.x = pk8(h0 * S8_H, h1 * S8_H, h2 * S8_H, h3 * S8_H); w8.y = pk8(h4 * S8_H, h5 * S8_H, h6 * S8_H, h7 * S8_H); *(u32x2*)(h8 + (o2 >> 1)) = w8; } }
                if (NORM) { sq += __shfl_xor(sq, 16); sq += __shfl_xor(sq, 32); sqv[m] = sq; } }
            if (NORM) { const float sqm = fq == 0 ? sqv[0] : fq == 1 ? sqv[1] : fq == 2 ? sqv[2] : sqv[3]; ss[(size_t)(row0 + ai * HALF + fq * 16) * 16 + 4 * u.pn + wc] = sqm; }
        }
    }
};

#ifndef PROBE_REP
#define PROBE_REP 1
#endif
template <class E> constexpr int epi_rep = 1;
template <> constexpr int epi_rep<EpiBf16<0, ST_MODE>> = PROBE_REP;
template <class Epi, class Sched, bool GATHER, int RS = 0, bool F8 = false>
DI void gemm_phase(int tid_in, LAS unsigned char* lds, const Gemm g, const Sched& S, const Epi& E, const LAS int* gtab, const LAS float* rtab = nullptr) {
    int tid_ = tid_in; asm volatile("" : "+v"(tid_));
    const int tid = tid_, wid = __builtin_amdgcn_readfirstlane(tid >> 6), lane = tid & 63, wr = wid >> 2, wc = wid & 3, fr = lane & 15, fq = lane >> 4;
    const int K = g.K, nt = K / BK;
    unsigned vB[2], vA[2][2]; int rA[2]; unsigned cC[2];
#pragma unroll
    for (int i = 0; i < 2; ++i) { int R, C; stage_rc(tid * 16 + i * 8192, R, C); const int Rb = Epi::PERM ? ((R & ~31) + perm32(R & 31)) : R;
        rA[i] = R; cC[i] = (unsigned)C * 2u; vB[i] = (unsigned)(Rb * K + C) * 2u;
        vA[0][i] = (unsigned)(R * g.lda + C) * 2u; vA[1][i] = vA[0][i]; }
    const size_t kstepA = (size_t)g.kstepA, kstepB = (size_t)(BK * 2), hstepB = (size_t)HALF * K * 2, hstepA = GATHER ? (size_t)0 : (size_t)HALF * g.lda * 2;
    const unsigned ldsw = (unsigned)wid * 1024u;
    const int aoff = lds_byte(wr * 64 + fr, fq * 8), boff = lds_byte(wc * 32 + fr, fq * 8);
#define PG8_SA(b, h) (((b) * 2 + (h)) * HTB)
#define PG8_SB(b, h) ((4 + (b) * 2 + (h)) * HTB)
#define PG8_STAGE(bufoff, gbase, voff) do { _Pragma("unroll") for (int _i = 0; _i < 2; ++_i) \
        __builtin_amdgcn_global_load_lds((const unsigned*)((const char*)(gbase) + (voff)[_i]), (LAS unsigned*)(lds + (bufoff) + ldsw + _i * 8192), 16, 0, 0); } while (0)
#define PG8_LDA(dst, b, h) do { _Pragma("unroll") for (int m = 0; m < 4; ++m) _Pragma("unroll") for (int k = 0; k < 2; ++k) dst[m][k] = *(const LAS bf16x8*)(lds + PG8_SA(b, h) + aoff + m * 2048 + k * 1024); } while (0)
#define PG8_LDB(dst, b, h) do { _Pragma("unroll") for (int n = 0; n < 2; ++n) _Pragma("unroll") for (int k = 0; k < 2; ++k) dst[n][k] = *(const LAS bf16x8*)(lds + PG8_SB(b, h) + boff + n * 2048 + k * 1024); } while (0)
#define PG8_CAT(x0, x1) __builtin_shufflevector(__builtin_bit_cast(i32x4_t, (x0)), __builtin_bit_cast(i32x4_t, (x1)), 0, 1, 2, 3, 4, 5, 6, 7)
#define PG8_MMA(ai, bj, At, Bt) do { __builtin_amdgcn_s_setprio(1); _Pragma("unroll") for (int m = 0; m < 4; ++m) _Pragma("unroll") for (int n = 0; n < 2; ++n) { \
        if constexpr (F8) asm volatile("v_mfma_f32_16x16x128_f8f6f4 %0, %1, %2, %0" : "+v"(acc[ai][bj][m][n]) : "v"(PG8_CAT(Bt[n][0], Bt[n][1])), "v"(PG8_CAT(At[m][0], At[m][1]))); \
        else { _Pragma("unroll") for (int k = 0; k < 2; ++k) acc[ai][bj][m][n] = __builtin_amdgcn_mfma_f32_16x16x32_bf16(Bt[n][k], At[m][k], acc[ai][bj][m][n], 0, 0, 0); } } \
        __builtin_amdgcn_s_setprio(0); } while (0)
#define PG8_WAIT_V(n) asm volatile("s_waitcnt vmcnt(" #n ")" ::: "memory")
#define PG8_WAIT_L(n) asm volatile("s_waitcnt lgkmcnt(" #n ")" ::: "memory")
#define PG8_BAR __builtin_amdgcn_s_barrier()
#define PG8_SCHED __builtin_amdgcn_sched_barrier(0)
#define PG8_GROWS(dst, slot) do { if constexpr (GATHER) { _Pragma("unroll") for (int _h = 0; _h < 2; ++_h) _Pragma("unroll") for (int _i = 0; _i < 2; ++_i) \
        dst[_h][_i] = (unsigned)gtab[(slot) * 256 + _h * HALF + rA[_i]] * (unsigned)(g.lda * 2) + cC[_i]; } } while (0)
    Unit cur, nxt; int ui = 0;
    if (!S.next(0, cur)) return;
    f32x4 acc[2][2][4][2];
#pragma unroll
    for (int a = 0; a < 2; ++a)
#pragma unroll
        for (int b = 0; b < 2; ++b)
#pragma unroll
            for (int m = 0; m < 4; ++m)
#pragma unroll
                for (int n = 0; n < 2; ++n) acc[a][b][m][n] = (f32x4){0.f, 0.f, 0.f, 0.f};
    bf16x8 At[4][2], B0[2][2], B1[2][2];
    const char* cA = (const char*)g.A + S.a_off(cur); const char* cB = (const char*)g.Bt + S.b_off(cur);
    PG8_GROWS(vA, 0);
    int rslot = 0;
#define PG8_LOADRS() do { _Pragma("unroll") for (int _a = 0; _a < 2; ++_a) _Pragma("unroll") for (int _m = 0; _m < 4; ++_m) \
        rs[_a][_m] = (RS == 1) ? rtab[rslot * 256 + _a * HALF + wr * 64 + _m * 16 + fr] : 1.0f; } while (0)
    PG8_STAGE(PG8_SB(0, 0), cB, vB); PG8_STAGE(PG8_SB(0, 1), cB + hstepB, vB); PG8_STAGE(PG8_SA(0, 0), cA, vA[0]); PG8_STAGE(PG8_SA(0, 1), cA + hstepA, vA[1]);
    if (wr == 1) PG8_BAR;
    PG8_WAIT_V(2); PG8_BAR;
    PG8_STAGE(PG8_SB(1, 0), cB + kstepB, vB); PG8_STAGE(PG8_SA(1, 0), cA + kstepA, vA[0]); PG8_STAGE(PG8_SB(1, 1), cB + hstepB + kstepB, vB);
    PG8_WAIT_V(6); PG8_BAR;
    for (;;) {
        const bool has_next = S.next(ui + 1, nxt);
        const char* nA = has_next ? (const char*)g.A + S.a_off(nxt) : cA; const char* nB = has_next ? (const char*)g.Bt + S.b_off(nxt) : cB;

#pragma nounroll
        for (int t = 0; t < nt; t += 2) {
            const bool last = (t == nt - 2);
            const char* a1 = cA + (size_t)(t + 1) * kstepA;
            const char* a2 = last ? nA : cA + (size_t)(t + 2) * kstepA; const char* b2 = last ? nB : cB + (size_t)(t + 2) * kstepB;
            const char* a3 = a2 + kstepA; const char* b3 = b2 + kstepB;
            PG8_LDB(B0, 0, 0); PG8_LDB(B1, 0, 1); PG8_SCHED; PG8_LDA(At, 0, 0); PG8_STAGE(PG8_SA(1, 1), a1 + hstepA, vA[1]);
            PG8_WAIT_V(8); PG8_WAIT_L(0); PG8_BAR; PG8_MMA(0, 0, At, B0); PG8_MMA(0, 1, At, B1); PG8_BAR; PG8_SCHED;
            if constexpr (GATHER) { if (last && has_next) { PG8_GROWS(vA, rslot + (nxt.pm != cur.pm ? 1 : 0)); } }
            PG8_LDA(At, 0, 1); PG8_STAGE(PG8_SB(0, 0), b2, vB); PG8_STAGE(PG8_SB(0, 1), b2 + hstepB, vB); PG8_STAGE(PG8_SA(0, 0), a2, vA[0]);
            PG8_WAIT_V(8); PG8_WAIT_L(0); PG8_BAR; PG8_MMA(1, 0, At, B0); PG8_MMA(1, 1, At, B1); PG8_BAR; PG8_SCHED;
            PG8_LDB(B0, 1, 0); PG8_LDB(B1, 1, 1); PG8_SCHED; PG8_LDA(At, 1, 0); PG8_STAGE(PG8_SA(0, 1), a2 + hstepA, vA[1]);
            PG8_WAIT_V(8); PG8_WAIT_L(0); PG8_BAR; PG8_MMA(0, 0, At, B0); PG8_MMA(0, 1, At, B1); PG8_BAR; PG8_SCHED;
            PG8_LDA(At, 1, 1); PG8_STAGE(PG8_SB(1, 0), b3, vB); PG8_STAGE(PG8_SB(1, 1), b3 + hstepB, vB); PG8_STAGE(PG8_SA(1, 0), a3, vA[0]);
            PG8_WAIT_V(8); PG8_WAIT_L(0); PG8_BAR; PG8_MMA(1, 0, At, B0); PG8_MMA(1, 1, At, B1); PG8_BAR; PG8_SCHED;
        }
        if constexpr (F8) asm volatile("s_nop 15\n\ts_nop 15" ::: "memory");
        if (wr == 0) PG8_BAR;
        float rs[2][4];
        PG8_LOADRS();
#pragma unroll
        for (int er = 0; er < epi_rep<Epi>; ++er) E(acc, cur, wr, wc, fr, fq, rs);
        if (!has_next) break;
#pragma unroll
        for (int a = 0; a < 2; ++a)
#pragma unroll
            for (int b = 0; b < 2; ++b)
#pragma unroll
                for (int m = 0; m < 4; ++m)
#pragma unroll
                    for (int n = 0; n < 2; ++n) acc[a][b][m][n] = (f32x4){0.f, 0.f, 0.f, 0.f};
        if (nxt.pm != cur.pm) ++rslot;
        cur = nxt; cA = nA; cB = nB; ++ui;
        if (wr == 1) PG8_BAR;
    }
    PG8_WAIT_V(0);
    PG8_BAR;
#undef PG8_SA
#undef PG8_SB
#undef PG8_STAGE
#undef PG8_LDA
#undef PG8_LDB
#undef PG8_MMA
#undef PG8_CAT
#undef PG8_WAIT_V
#undef PG8_WAIT_L
#undef PG8_BAR
#undef PG8_SCHED
#undef PG8_GROWS
#undef PG8_LOADRS
}
}

#define XB_TMO      128
#define XB_XCNT(j)  (256  + 64 * (j))
#define XB_XSUB(j)  (1280 + 64 * (j))
#define XB_XGEN(j)  (2304 + 64 * (j))
#define XB_TOP      3328
#define XB_TOPGEN   3392
#define XCD_BAR_WORDS 3456
#define XB_SPIN_CAP (1u << 22)
DI unsigned xb_ld(unsigned* p)              { return __hip_atomic_load(p, __ATOMIC_RELAXED, __HIP_MEMORY_SCOPE_AGENT); }
DI unsigned xb_add(unsigned* p, unsigned v) { return __hip_atomic_fetch_add(p, v, __ATOMIC_RELAXED, __HIP_MEMORY_SCOPE_AGENT); }
DI int lane_now() { unsigned z = 0u; asm volatile("" : "+v"(z)); return (int)__builtin_amdgcn_mbcnt_hi(~0u, __builtin_amdgcn_mbcnt_lo(~0u, z)); }
DI unsigned xb_xcc_id() { return (unsigned)__builtin_amdgcn_s_getreg((3 << 11) | 20) & 0xFu; }
#define XB_SPIN(cond, bar) do { unsigned _sp = 0; while (cond) { __builtin_amdgcn_s_sleep(1); \
    if ((++_sp & 255u) == 0u) { if (xb_ld(&(bar)[XB_TMO])) break; if (_sp > XB_SPIN_CAP) { atomicAdd(&(bar)[XB_TMO], 1u); break; } } } } while (0)
struct XcdBarrier { unsigned* bar; unsigned x; volatile LAS unsigned* st; };
DI XcdBarrier xcd_barrier_post(unsigned* bar, volatile LAS unsigned* st, int wave0) {
    XcdBarrier b; b.bar = bar; b.x = xb_xcc_id(); b.st = st;
    if ((wave0 * 64 + lane_now()) == 0) (void)xb_add(&bar[XB_XCNT(b.x)], 1u);
    return b;
}
DI void xcd_barrier_complete(unsigned* bar, unsigned x, unsigned& nloc, unsigned& nx) {
    const unsigned G = gridDim.x * gridDim.y * gridDim.z;
    unsigned sum, cnt, mine, sp = 0u;
    for (;;) {
        sum = 0u; cnt = 0u; mine = 0u;
#pragma unroll
        for (unsigned j = 0; j < 16; ++j) { const unsigned c = xb_ld(&bar[XB_XCNT(j)]); sum += c; cnt += (c > 0u) ? 1u : 0u; mine = (j == x) ? c : mine; }
        if (sum == G) break;
        __builtin_amdgcn_s_sleep(1);
        if ((++sp & 255u) == 0u) { if (xb_ld(&bar[XB_TMO])) break; if (sp > XB_SPIN_CAP) { atomicAdd(&bar[XB_TMO], 1u); break; } }
    }
    nloc = mine > 0u ? mine : 1u; nx = cnt > 0u ? cnt : 1u;
}
DI void xcd_barrier(const XcdBarrier& b, int wave0) {
    asm volatile("s_waitcnt vmcnt(0)" ::: "memory");
    __syncthreads();
    if ((wave0 * 64 + lane_now()) == 0) {
        unsigned bx = b.x; GAS unsigned* barg = (GAS unsigned*)b.bar; asm volatile("" : "+s"(bx), "+s"(barg)); unsigned* bar = (unsigned*)barg;
        __builtin_amdgcn_s_waitcnt(0);
        unsigned nloc = b.st[0], nx = b.st[1];
        if (nloc == 0u) { xcd_barrier_complete(bar, bx, nloc, nx); b.st[0] = nloc; b.st[1] = nx; }
        const unsigned old = xb_add(&bar[XB_XSUB(bx)], 1u);
        const unsigned gen = old / nloc;
        if (old + 1u == (gen + 1u) * nloc) {
            __builtin_amdgcn_fence(__ATOMIC_RELEASE, "agent");
            asm volatile("s_waitcnt vmcnt(0)" ::: "memory");
            const unsigned og = xb_add(&bar[XB_TOP], 1u);
            const unsigned tg = og / nx;
            if (og + 1u == (tg + 1u) * nx) xb_add(&bar[XB_TOPGEN], 1u);
            else XB_SPIN(xb_ld(&bar[XB_TOPGEN]) == tg, bar);
            __builtin_amdgcn_fence(__ATOMIC_ACQUIRE, "agent");
            xb_add(&bar[XB_XGEN(bx)], 1u);
            asm volatile("s_waitcnt vmcnt(0)" ::: "memory");
        } else {
            XB_SPIN(xb_ld(&bar[XB_XGEN(bx)]) == gen, bar);
            __builtin_amdgcn_fence(__ATOMIC_ACQUIRE, "agent");
            asm volatile("s_waitcnt vmcnt(0)" ::: "memory");
        }
    }
    __syncthreads();
}

struct Args { const float* in[21]; float* out; unsigned char* ws; };
enum { I_X = 0, I_P, I_WIN, I_WOUT, I_GMIX, I_GFFN, I_GPLE, I_GFINAL, I_CPOS, I_CW1, I_CW2, I_RETGN, I_FGATE, I_FUP, I_FDOWN, I_ROUTER, I_MGATE, I_MUP, I_MDOWN, I_PPROJ, I_PGATE };
struct Frame { LAS unsigned char* lds; unsigned char* ws; int tid, lane, wave, G, bid, wave0; };

DI void relaunder(Frame& F) { int w = __builtin_amdgcn_readfirstlane(F.wave0), l = lane_now(); asm volatile("" : "+s"(w), "+v"(l)); F.wave0 = w; F.tid = w * 64 + l; F.lane = l; F.wave = w;
    int g = (int)gridDim.x, b = (int)blockIdx.x; asm volatile("" : "+s"(g), "+s"(b)); F.G = g; F.bid = b; }

struct Seg { const float* src; bf16* dst; int K, Nsrc, nsrc0, ncols, nvalid, ndst0, ilv; const float* gain; int f8; float wsc; };
constexpr int NSEG = 2 * 8 + 3 + NE * 3;
DI Seg seg_decode(const Args& a, int s) {
    Seg g; unsigned char* ws = a.ws;
    if (s < 16) { const int L = s >> 3, k = s & 7; unsigned char* wl = ws + WS_W + L * WL_STRIDE;
        if (k == 0) g = Seg{a.in[I_WIN] + (size_t)L * D * IN_COLS, (bf16*)(wl + WL_WIN), D, IN_COLS, 0, 1280, 1280, 0, 0, a.in[I_GMIX] + L * D, (F8_IN1 && L == 1) ? 1 : 0, S8_WU};
        else if (k == 1) g = Seg{a.in[I_WIN] + (size_t)L * D * IN_COLS, (bf16*)(wl + WL_WIN), D, IN_COLS, 1304, 2048, 2048, 1280, 0, a.in[I_GMIX] + L * D, (F8_IN1 && L == 1) ? 1 : 0, S8_WU};
        else if (k == 2) g = Seg{a.in[I_WIN] + (size_t)L * D * IN_COLS, (bf16*)(wl + WL_WIN), D, IN_COLS, 1280, 256, 24, 3328, 0, a.in[I_GMIX] + L * D, (F8_IN1 && L == 1) ? 1 : 0, S8_WU};
        else if (k == 3) g = Seg{a.in[I_WOUT] + (size_t)L * D * D, (bf16*)(wl + WL_WOUT), D, D, 0, D, D, 0, 0, nullptr};
        else if (k == 4) g = Seg{a.in[I_PGATE] + (size_t)L * D * D, (bf16*)(wl + WL_PGATE), D, D, 0, D, D, 0, 0, a.in[I_GPLE] + L * D, F8_GATE, S8_WU};
        else if (k == 5) g = Seg{a.in[I_PPROJ] + (size_t)L * PLE * D, (bf16*)(wl + WL_PPROJ), PLE, D, 0, D, D, 0, 0, nullptr};
        else { const int which = k - 6; g = Seg{a.in[I_CW1] + (size_t)(L * 2 + which) * 2048 * 256, (bf16*)(wl + WL_CW1) + (size_t)which * 256 * 2048, 2048, 256, 0, 256, 256, 0, 0, nullptr}; }
    } else if (s < 19) { const int k = s - 16;
        if (k == 0) g = Seg{a.in[I_FGATE], (bf16*)(ws + WS_WDENSE), D, DFF, 0, DFF, DFF, 0, 1, a.in[I_GFFN], F8_DUP, S8_WU};
        else if (k == 1) g = Seg{a.in[I_FUP], (bf16*)(ws + WS_WDENSE), D, DFF, 0, DFF, DFF, 0, 2, a.in[I_GFFN], F8_DUP, S8_WU};
        else g = Seg{a.in[I_FDOWN], (bf16*)(ws + WS_WDENSE + 14 * MiB), DFF, D, 0, D, D, 0, 0, nullptr, F8_DDN, S8_WD};
    } else { const int e = (s - 19) / 3, k = (s - 19) % 3; unsigned char* we = ws + WS_WMOE + (size_t)e * WE_STRIDE;
        if (k == 0) g = Seg{a.in[I_MGATE] + (size_t)e * D * DFF, (bf16*)we, D, DFF, 0, DFF, DFF, 0, 1, a.in[I_GFFN] + D, F8_MOE, S8_WU};
        else if (k == 1) g = Seg{a.in[I_MUP] + (size_t)e * D * DFF, (bf16*)we, D, DFF, 0, DFF, DFF, 0, 2, a.in[I_GFFN] + D, F8_MOE, S8_WU};
        else g = Seg{a.in[I_MDOWN] + (size_t)e * DFF * D, (bf16*)(we + WE_DOWN), DFF, D, 0, D, D, 0, 0, nullptr, F8_MOE, S8_WD};
    }
    return g;
}
DI void transpose_load(const Seg& g, int item, int lane, f32x4 (&r)[8]) {
    const int nblk = g.ncols / 32, kb = item / nblk, nb = item % nblk, k0 = 64 * kb, n0 = 32 * nb;
    const int c4 = (lane & 7) * 4; const int nv = g.nvalid - n0;
#pragma unroll
    for (int i = 0; i < 8; ++i) { const int kk = i * 8 + (lane >> 3); r[i] = (c4 < nv) ? *(const f32x4*)(g.src + (size_t)(k0 + kk) * g.Nsrc + g.nsrc0 + n0 + c4) : (f32x4){0.f, 0.f, 0.f, 0.f};
        if (g.gain) r[i] = r[i] * g.gain[k0 + kk]; }
}
DI void transpose_store(const Seg& g, LAS float* scr, int item, int lane, const f32x4 (&r)[8]) {
    const int nblk = g.ncols / 32, kb = item / nblk, nb = item % nblk, k0 = 64 * kb, n0 = 32 * nb;
    const int c4 = (lane & 7) * 4;
#pragma unroll
    for (int i = 0; i < 8; ++i) { const int kk = i * 8 + (lane >> 3); LAS float* d = scr + kk * 33 + c4; d[0] = r[i][0]; d[1] = r[i][1]; d[2] = r[i][2]; d[3] = r[i][3]; }
    asm volatile("s_waitcnt lgkmcnt(0)" ::: "memory");
    const int c8 = lane & 7;
#pragma unroll
    for (int j = 0; j < 4; ++j) { const int n = (lane >> 3) + 8 * j; const LAS float* s = scr + (8 * c8) * 33 + n;
        const int na = n0 + n; const int drow = g.ilv ? ((na >> 7) * 256 + (na & 127) + (g.ilv == 2 ? 128 : 0)) : (g.ndst0 + na);
        if (g.f8) { const float c = g.wsc; u32x2 o; o.x = pk8(s[0 * 33] * c, s[1 * 33] * c, s[2 * 33] * c, s[3 * 33] * c); o.y = pk8(s[4 * 33] * c, s[5 * 33] * c, s[6 * 33] * c, s[7 * 33] * c);
            *(u32x2*)((unsigned char*)g.dst + (size_t)drow * g.K + k0 + 8 * c8) = o; }
        else { u32x4 o; o.x = pk(s[0 * 33], s[1 * 33]); o.y = pk(s[2 * 33], s[3 * 33]); o.z = pk(s[4 * 33], s[5 * 33]); o.w = pk(s[6 * 33], s[7 * 33]);
            *(u32x4*)(g.dst + (size_t)drow * g.K + k0 + 8 * c8) = o; } }
    asm volatile("s_waitcnt lgkmcnt(0)" ::: "memory");
}

DI void row_load(const float* row, int lane, f32x4 (&v)[4]) {
#pragma unroll
    for (int j = 0; j < 4; ++j) v[j] = *(const f32x4*)(row + 4 * lane + 256 * j);
}
DI float row_rstd(const f32x4 (&v)[4]) {
    float s = 0.f;
#pragma unroll
    for (int j = 0; j < 4; ++j) s += (v[j][0] * v[j][0] + v[j][1] * v[j][1]) + (v[j][2] * v[j][2] + v[j][3] * v[j][3]);
    return 1.0f / sqrtf(wave_sum(s) * (1.f / D) + EPS);
}
DI void row_store_bf16(bf16* orow, int lane, const f32x4 (&y)[4]) {
#pragma unroll
    for (int j = 0; j < 4; ++j) { u32x2 w; w.x = pk(y[j][0], y[j][1]); w.y = pk(y[j][2], y[j][3]); *(u32x2*)(orow + 4 * lane + 256 * j) = w; }
}
DI void row_load16(const bf16* row, int lane, f32x4 (&v)[4]) {
#pragma unroll
    for (int j = 0; j < 4; ++j) { const u32x2 w = *(const u32x2*)(row + 4 * lane + 256 * j); v[j] = (f32x4){bflo(w.x), bfhi(w.x), bflo(w.y), bfhi(w.y)}; }
}
DI void norm_first(Frame& F, const float* src, bf16* H16, float* rstd) {
    const int gw = F.bid * NWAVES + F.wave, NGW = F.G * NWAVES;
    for (int m = gw; m < T; m += NGW) { f32x4 v[4]; row_load(src + (size_t)m * D, F.lane, v); const float r = row_rstd(v);
        row_store_bf16(H16 + (size_t)m * D, F.lane, v); if (F.lane == 0) rstd[m] = r; }
}
DI void pb_convert(Frame& F, const float* p, bf16* PBo) {
    const size_t n8 = (size_t)2 * T * PLE / 8;
    for (size_t i = (size_t)F.bid * NTHR + F.tid; i < n8; i += (size_t)F.G * NTHR) { const f32x4 a = *(const f32x4*)(p + 8 * i), b = *(const f32x4*)(p + 8 * i + 4);
        u32x4 w; w.x = pk(a[0], a[1]); w.y = pk(a[2], a[3]); w.z = pk(b[0], b[1]); w.w = pk(b[2], b[3]); *(u32x4*)(PBo + 8 * i) = w; }
}
DI void norm_final(Frame& F, const bf16* H16, const float* gain, float* out) {
    f32x4 gv[4]; row_load(gain, F.lane, gv);
    const int gw = F.bid * NWAVES + F.wave, NGW = F.G * NWAVES;
    for (int m = gw; m < T; m += NGW) { f32x4 v[4]; row_load16(H16 + (size_t)m * D, F.lane, v); const float r = row_rstd(v);
#pragma unroll
        for (int j = 0; j < 4; ++j) *(f32x4*)(out + (size_t)m * D + 4 * F.lane + 256 * j) = v[j] * r * gv[j]; }
}
template <bool FROM_SS, class Sched> DI void fill_rtab(Frame& F, const Sched& S, LAS float* rtab, const float* src) {
    LAS int* ui = (LAS int*)(F.lds + UINFO_OFF);
    pg8::Unit u; int ns = 0, last = -1;
    for (int i = 0; S.next(i, u); ++i) if (u.pm != last) { last = u.pm; if (ns < 15 && F.tid == 0) ui[4 * ns + 3] = u.pm; ++ns; }
    __syncthreads();
    const int nsl = ns < 15 ? ns : 15, r = F.tid & 255, s0 = F.tid >> 8;
    for (int sb = 0; sb < nsl; sb += 8) {
        f32x4 q[4][4]; float rr[4];
#pragma unroll
        for (int j = 0; j < 4; ++j) { const int sl = sb + s0 + 2 * j; if (sl < nsl) { const size_t row = (size_t)ui[4 * sl + 3] * 256 + r;
            if (FROM_SS) { const f32x4* p = (const f32x4*)(src + row * 16); q[j][0] = p[0]; q[j][1] = p[1]; q[j][2] = p[2]; q[j][3] = p[3]; } else rr[j] = src[row]; } }
#pragma unroll
        for (int j = 0; j < 4; ++j) { const int sl = sb + s0 + 2 * j; if (sl < nsl) { float rv;
            if (FROM_SS) { const f32x4 a = q[j][0], b = q[j][1], c = q[j][2], d = q[j][3];
                float t = 0.f; t += a[0]; t += a[1]; t += a[2]; t += a[3]; t += b[0]; t += b[1]; t += b[2]; t += b[3]; t += c[0]; t += c[1]; t += c[2]; t += c[3]; t += d[0]; t += d[1]; t += d[2]; t += d[3];
                rv = 1.0f / sqrtf(t * (1.f / D) + EPS); }
            else rv = rr[j];
            rtab[sl * 256 + r] = rv; } }
    }
    __syncthreads();
}
DI float rstd_from_ss(const float* ss, int row) { const f32x4* p = (const f32x4*)(ss + (size_t)row * 16); const f32x4 a = p[0], b = p[1], c = p[2], d = p[3];
    float t = 0.f; t += a[0]; t += a[1]; t += a[2]; t += a[3]; t += b[0]; t += b[1]; t += b[2]; t += b[3]; t += c[0]; t += c[1]; t += c[2]; t += c[3]; t += d[0]; t += d[1]; t += d[2]; t += d[3];
    return 1.0f / sqrtf(t * (1.f / D) + EPS); }
DI void moe_combine(Frame& F, bf16* H16, unsigned char* G8, float* rstd, const unsigned char* YP, const int* tokrow, const float* tokinfo) {
    const int gw = F.bid * NWAVES + F.wave, NGW = F.G * NWAVES;
    for (int m = gw; m < T; m += NGW) { f32x4 v[4]; row_load16(H16 + (size_t)m * D, F.lane, v);
        const int r0 = tokrow[2 * m], r1 = tokrow[2 * m + 1]; const float w0 = tokinfo[4 * m + 2] * (1.0f / S8_Y), w1 = tokinfo[4 * m + 3] * (1.0f / S8_Y);
#pragma unroll
        for (int j = 0; j < 4; ++j) { const int a = *(const int*)(YP + (size_t)r0 * D + 4 * F.lane + 256 * j), b = *(const int*)(YP + (size_t)r1 * D + 4 * F.lane + 256 * j);
            const f32x2 a0 = __builtin_amdgcn_cvt_pk_f32_fp8(a, false), a1 = __builtin_amdgcn_cvt_pk_f32_fp8(a, true), b0 = __builtin_amdgcn_cvt_pk_f32_fp8(b, false), b1 = __builtin_amdgcn_cvt_pk_f32_fp8(b, true);
            v[j][0] += w0 * a0[0] + w1 * b0[0]; v[j][1] += w0 * a0[1] + w1 * b0[1]; v[j][2] += w0 * a1[0] + w1 * b1[0]; v[j][3] += w0 * a1[1] + w1 * b1[1]; }
        const float r = row_rstd(v);
        row_store_bf16(H16 + (size_t)m * D, F.lane, v); if (F.lane == 0) rstd[m] = r;
        if (F8_GATE) {
#pragma unroll
            for (int j = 0; j < 4; ++j) *(unsigned*)(G8 + (size_t)m * D + 4 * F.lane + 256 * j) = pk8(v[j][0] * S8_H, v[j][1] * S8_H, v[j][2] * S8_H, v[j][3] * S8_H); } }
}
DI void norm_router(Frame& F, const bf16* H16, const float* gain, const float* router, float* tokinfo, int* bcnt) {
    LAS int* sel = (LAS int*)(F.lds + 32768);
    LAS float* wts = (LAS float*)(F.lds + 32768 + 1024);
    LAS int* pib = (LAS int*)(F.lds + 32768 + 1024 + 2048);
    f32x4 gv[4]; row_load(gain, F.lane, gv);
    f32x4 rw[4][4][2];
#pragma unroll
    for (int j = 0; j < 4; ++j)
#pragma unroll
        for (int q = 0; q < 4; ++q) { const int c = 4 * F.lane + 256 * j + q; rw[j][q][0] = *(const f32x4*)(router + c * 8); rw[j][q][1] = *(const f32x4*)(router + c * 8 + 4); }
    for (int blk = F.bid; blk < T / 256; blk += F.G) {
        for (int i = 0; i < 32; ++i) { const int rl = F.wave * 32 + i, m = blk * 256 + rl; f32x4 v[4]; row_load16(H16 + (size_t)m * D, F.lane, v); const float r = row_rstd(v);
            float lg[NE];
#pragma unroll
            for (int e = 0; e < NE; ++e) lg[e] = 0.f;
#pragma unroll
            for (int j = 0; j < 4; ++j) { v[j] = v[j] * r * gv[j];
#pragma unroll
                for (int q = 0; q < 4; ++q) { const f32x4 r0 = rw[j][q][0], r1 = rw[j][q][1];
                    lg[0] += v[j][q] * r0[0]; lg[1] += v[j][q] * r0[1]; lg[2] += v[j][q] * r0[2]; lg[3] += v[j][q] * r0[3]; lg[4] += v[j][q] * r1[0]; lg[5] += v[j][q] * r1[1]; lg[6] += v[j][q] * r1[2]; lg[7] += v[j][q] * r1[3]; } }
#pragma unroll
            for (int e = 0; e < NE; ++e) lg[e] = wave_sum(lg[e]);
            int e0 = 0; float v0 = lg[0];
#pragma unroll
            for (int e = 1; e < NE; ++e) if (lg[e] > v0) { v0 = lg[e]; e0 = e; }
            int e1 = -1; float v1 = -3.0e38f;
#pragma unroll
            for (int e = 0; e < NE; ++e) if (e != e0 && lg[e] > v1) { v1 = lg[e]; e1 = e; }
            const float w0 = 1.f / (1.f + __expf(v1 - v0));
            if (F.lane == 0) { sel[rl] = e0 | (e1 << 8); wts[2 * rl] = w0; wts[2 * rl + 1] = 1.f - w0; }
        }
        __syncthreads();
        LAS int* p0 = pib; LAS int* p1 = pib + 256;
        if (F.tid < NE) { const int e = F.tid; int cnt = 0;
            for (int rl = 0; rl < 256; ++rl) { const int s = sel[rl]; if ((s & 255) == e) p0[rl] = cnt++; if ((s >> 8) == e) p1[rl] = cnt++; }
            bcnt[blk * NE + e] = cnt; }
        __syncthreads();
        if (F.tid < 256) { const int m = blk * 256 + F.tid; f32x4 o; o[0] = __int_as_float(sel[F.tid]); o[1] = __int_as_float(p0[F.tid] | (p1[F.tid] << 16)); o[2] = wts[2 * F.tid]; o[3] = wts[2 * F.tid + 1]; *(f32x4*)(tokinfo + 4 * (size_t)m) = o; }
        __syncthreads();
    }
}
DI void moe_index(Frame& F, const int* bcnt, const float* tokinfo, int* tokrow, int* rowtok, int* meta) {
    LAS int* C = (LAS int*)F.lds;
    LAS int* tot = C + 2048; LAS int* base = tot + 8; LAS int* off = base + 8;
    for (int i = F.tid; i < 2048; i += NTHR) C[i] = bcnt[i];
    __syncthreads();
    for (int blk = F.bid; blk < T / 256; blk += F.G) {
        if (F.tid < NE) { int t = 0, b = 0; for (int k = 0; k < 256; ++k) { const int c = C[k * NE + F.tid]; if (k < blk) b += c; t += c; } tot[F.tid] = t; base[F.tid] = b; }
        __syncthreads();
        if (F.tid == 0) { int o = 0; for (int e = 0; e < NE; ++e) { off[e] = o; o += (tot[e] + 255) & ~255; } off[NE] = o; }
        __syncthreads();
        if (F.tid < 256) { const int m = blk * 256 + F.tid; const f32x4 ti = *(const f32x4*)(tokinfo + 4 * (size_t)m); const int s = __float_as_int(ti[0]), pp = __float_as_int(ti[1]);
            const int e0 = s & 255, e1 = s >> 8; const int r0 = off[e0] + base[e0] + (pp & 0xffff), r1 = off[e1] + base[e1] + (pp >> 16);
            rowtok[r0] = m; rowtok[r1] = m; tokrow[2 * m] = r0; tokrow[2 * m + 1] = r1; }
        if (blk < NE) { const int e = blk; for (int r = tot[e] + F.tid; r < ((tot[e] + 255) & ~255); r += NTHR) rowtok[off[e] + r] = 0; }
        if (blk == 0) { const int np = off[NE] >> 8; if (F.tid == 0) meta[0] = np;
            for (int p = F.tid; p < np; p += NTHR) { int e = 0;
#pragma unroll
                for (int k = 1; k < NE; ++k) if (p * 256 >= off[k]) e = k;
                meta[16 + p] = e; } }
        __syncthreads();
    }
}

DI int slot_of(int key) { const int kl = key & 31; return (key & ~31) + 8 * ((kl >> 2) & 3) + 4 * (kl >> 4) + (kl & 3); }
DI float log2_gamma(int h) { return log2f(1.0f - exp2f(-5.0f - (float)h)); }
struct RetKV { u32x4 k[2], v[2]; };
DI void ret_kv_load(Frame& F, const bf16* Z, int unit, RetKV& r) {
    const int bh = unit >> 6, c = unit & 63, b = bh >> 3, h = bh & 7; const size_t row0 = (size_t)b * SEQ + c * 128;
#pragma unroll
    for (int i = 0; i < 2; ++i) { const int p = i * 512 + F.tid, m = p >> 3, ch = p & 7;
        r.k[i] = *(const u32x4*)(Z + (row0 + m) * ZP + Z_KR + h * 64 + 8 * ch); r.v[i] = *(const u32x4*)(Z + (row0 + m) * ZP + Z_VR + h * 64 + 8 * ch); }
}
DI void ret_kv_compute(Frame& F, float* RETS, int unit, const RetKV& r, bool has_next, const bf16* Z, int next_unit, RetKV& rn) {
    const int h = (unit >> 6) & 7; const float lg = log2_gamma(h);
    LAS unsigned char* KI = F.lds; LAS unsigned char* VI = F.lds + 16384;
#pragma unroll
    for (int i = 0; i < 2; ++i) { const int p = i * 512 + F.tid, m = p >> 3, ch = p & 7;
        const float sc = 0.125f * fexp2((float)(127 - m) * lg);
        u32x4 kk; kk.x = pk(bflo(r.k[i].x) * sc, bfhi(r.k[i].x) * sc); kk.y = pk(bflo(r.k[i].y) * sc, bfhi(r.k[i].y) * sc); kk.z = pk(bflo(r.k[i].z) * sc, bfhi(r.k[i].z) * sc); kk.w = pk(bflo(r.k[i].w) * sc, bfhi(r.k[i].w) * sc);
        const int o = m * 128 + (tr_chunk(m, ch) << 4); *(LAS u32x4*)(KI + o) = kk; *(LAS u32x4*)(VI + o) = r.v[i]; }
    __syncthreads();
    if (has_next) ret_kv_load(F, Z, next_unit, rn);
    const int fr = F.lane & 15, fq = F.lane >> 4;
#pragma unroll
    for (int tt = 0; tt < 2; ++tt) { const int tile = 2 * F.wave + tt, et = tile >> 2, dt = tile & 3; f32x4 acc = {0.f, 0.f, 0.f, 0.f};
#pragma unroll
        for (int ks = 0; ks < 4; ++ks) acc = MFMA16(tr_frag(VI, ks, et, fr, fq), tr_frag(KI, ks, dt, fr, fq), acc);
        float* o = RETS + ((size_t)unit * 64) * 64;
#pragma unroll
        for (int v = 0; v < 4; ++v) o[(16 * et + 4 * fq + v) * 64 + 16 * dt + fr] = acc[v]; }
    __syncthreads();
}
DI void ret_kv_units(Frame& F, const bf16* Z, float* RETS, int u0, int step, int n) {
    if (n <= 0) return;
    RetKV ra, rb; ret_kv_load(F, Z, u0, ra);
#pragma nounroll
    for (int i = 0; i < n; ++i) { ret_kv_compute(F, RETS, u0 + i * step, ra, i + 1 < n, Z, u0 + (i + 1) * step, rb); ra = rb; }
}
DI void ret_scan(Frame& F, float* RETS) {
    for (int e = F.bid * NTHR + F.tid; e < 64 * 4096; e += F.G * NTHR) { const int bh = e >> 12, idx = e & 4095, h = bh & 7; const float gc = fexp2(128.f * log2_gamma(h));
        float* p = RETS + (size_t)bh * 64 * 4096 + idx; float st = 0.f;
        for (int c0 = 0; c0 < 64; c0 += 8) { float kv[8];
#pragma unroll
            for (int j = 0; j < 8; ++j) kv[j] = p[(size_t)(c0 + j) * 4096];
#pragma unroll
            for (int j = 0; j < 8; ++j) { p[(size_t)(c0 + j) * 4096] = st; st = gc * st + kv[j]; } } }
}
DI void cmp_out(Frame& F, const bf16* HIDC, const float* w2  , bf16* KCMP, bf16* VCMPT) {
    LAS bf16* WT = (LAS bf16*)F.lds; const int fr = F.lane & 15, fq = F.lane >> 4; int have = -1;
    for (int rb = F.bid; rb < 16384 / 64; rb += F.G) { const int R0 = rb * 64, combo = R0 >> 12, which = combo >> 1, g = combo & 1;
        if (which != have) { __syncthreads();
#pragma unroll
            for (int i = 0; i < 8; ++i) { const int e = (i * 512 + F.tid) * 4, k = e >> 6, d0 = e & 63; const f32x4 w = *(const f32x4*)(w2 + (size_t)which * 16384 + e);
                const unsigned p0 = pk(w[0], w[1]), p1 = pk(w[2], w[3]); WT[(d0 + 0) * 264 + k] = (bf16)(p0 & 0xffff); WT[(d0 + 1) * 264 + k] = (bf16)(p0 >> 16); WT[(d0 + 2) * 264 + k] = (bf16)(p1 & 0xffff); WT[(d0 + 3) * 264 + k] = (bf16)(p1 >> 16); }
            have = which; __syncthreads(); }
        const int rt = F.wave & 3, row = R0 + 16 * rt + fr; f32x4 acc[2] = {{0.f, 0.f, 0.f, 0.f}, {0.f, 0.f, 0.f, 0.f}};
#pragma unroll
        for (int ks = 0; ks < 8; ++ks) { const bf16x8 a = *(const bf16x8*)(HIDC + (size_t)row * 256 + 32 * ks + 8 * fq);
#pragma unroll
            for (int c = 0; c < 2; ++c) { const int ct = 2 * (F.wave >> 2) + c; const bf16x8 bb = *(const LAS bf16x8*)(WT + (16 * ct + fr) * 264 + 32 * ks + 8 * fq); acc[c] = MFMA16(a, bb, acc[c]); } }
        const int rq = R0 + 16 * rt + 4 * fq, bn = rq & 4095, bq = bn >> 9, n0 = bn & 511, bg = bq * 2 + g;
#pragma unroll
        for (int c = 0; c < 2; ++c) { const int dd = 16 * (2 * (F.wave >> 2) + c) + fr; float v4[4];
#pragma unroll
            for (int v = 0; v < 4; ++v) v4[v] = (n0 + v == 511) ? 0.f : acc[c][v];
            if (which == 0) {
#pragma unroll
                for (int v = 0; v < 4; ++v) KCMP[((size_t)bg * 512 + n0 + v) * 64 + dd] = (bf16)(pk(v4[v], 0.f) & 0xffff); }
            else {
#pragma unroll
                for (int v = 0; v < 4; ++v) VCMPT[((size_t)bg * 512 + n0 + v) * 64 + dd] = (bf16)(pk(v4[v], 0.f) & 0xffff); } }
    }
    __syncthreads();
}

namespace rto { constexpr int RAWK = 0, RAWV = 32768, RAWS = 65536, STO = RAWS + 16384, END = STO + 64 * 72 * 2; static_assert(END <= RING_BYTES, "ret_out lds"); }
DI void ret_out_dma(Frame& F, const bf16* Z, const float* RETS, int unit, int kbuf) {
    const int bh = unit >> 6, c = unit & 63, b = bh >> 3, h = bh & 7; const size_t row0 = (size_t)b * SEQ + c * 128;
    const unsigned l0 = (unsigned)(uintptr_t)F.lds;
#pragma unroll
    for (int j = 0; j < 2; ++j) { const int p = 2 * F.wave + j, row = 8 * p + (F.lane >> 3), cl = F.lane & 7;
        gl16((const char*)(Z + (row0 + row) * ZP + Z_KR + h * 64) + ((cl ^ ((row >> 1) & 7)) << 4), (unsigned)__builtin_amdgcn_readfirstlane(l0 + rto::RAWK + kbuf * 16384 + p * 1024));
        gl16((const char*)(Z + (row0 + row) * ZP + Z_VR + h * 64) + (tr_chunk(row, cl) << 4), (unsigned)__builtin_amdgcn_readfirstlane(l0 + rto::RAWV + kbuf * 16384 + p * 1024));
        gl16((const char*)(RETS + (size_t)unit * 4096) + p * 1024 + F.lane * 16, (unsigned)__builtin_amdgcn_readfirstlane(l0 + rto::RAWS + p * 1024)); }
}
DI int ret_out_unit(Frame& F, const bf16* Z, const float* RETS, const float* gn, bf16* AR, int unit, int kbuf, unsigned* qctr, LAS int* qslot) {
    int grabbed = 0; if (F.tid == 0) grabbed = (int)__hip_atomic_fetch_add(qctr, 1u, __ATOMIC_RELAXED, __HIP_MEMORY_SCOPE_AGENT);
    const int bh = unit >> 6, c = unit & 63, b = bh >> 3, h = bh & 7; const float lg = log2_gamma(h);
    const LAS unsigned char* Kl = F.lds + rto::RAWK + kbuf * 16384;
    const LAS unsigned char* VI = F.lds + rto::RAWV + kbuf * 16384;
    LAS bf16* ST = (LAS bf16*)(F.lds + rto::STO);
    const size_t row0 = (size_t)b * SEQ + c * 128;
    const int fr = F.lane & 15, fq = F.lane >> 4, w = F.wave, n = 16 * w + fr;
    bf16x8 q[2];
#pragma unroll
    for (int ks = 0; ks < 2; ++ks) q[ks] = *(const bf16x8*)(Z + (row0 + n) * ZP + Z_QR + h * 64 + 32 * ks + 8 * fq);
    u32x2 gsave[4];
#pragma unroll
    for (int et = 0; et < 4; ++et) gsave[et] = *(const u32x2*)(Z + (row0 + n) * ZP + Z_GR + h * 64 + 16 * et + 4 * fq);
    __builtin_amdgcn_s_waitcnt(0);
    __syncthreads();
    { const int e = F.tid >> 3, d0 = (F.tid & 7) * 8; const f32x4 s0 = *(const LAS f32x4*)(F.lds + rto::RAWS + (e * 64 + d0) * 4), s1 = *(const LAS f32x4*)(F.lds + rto::RAWS + (e * 64 + d0 + 4) * 4);
      u32x4 wv; wv.x = pk(s0[0], s0[1]); wv.y = pk(s0[2], s0[3]); wv.z = pk(s1[0], s1[1]); wv.w = pk(s1[2], s1[3]); *(LAS u32x4*)(ST + e * 72 + d0) = wv; }
    if (F.tid == 0) qslot[0] = grabbed;
    asm volatile("s_waitcnt lgkmcnt(0)" ::: "memory");
    __syncthreads();
    const int nq = F.G + __builtin_amdgcn_readfirstlane(qslot[0]);
    if (nq < 2048 + 4096) ret_out_dma(F, Z, RETS, nq - 2048, kbuf ^ 1);
    f32x4 s[8];
#pragma unroll
    for (int mt = 0; mt < 8; ++mt) { s[mt] = (f32x4){0.f, 0.f, 0.f, 0.f};
        if (mt <= w) {
#pragma unroll
            for (int ks = 0; ks < 2; ++ks) { const bf16x8 a = *(const LAS bf16x8*)(Kl + (16 * mt + fr) * 128 + (((4 * ks + fq) ^ ((fr >> 1) & 7)) << 4)); s[mt] = MFMA16(a, q[ks], s[mt]); }
#pragma unroll
            for (int v = 0; v < 4; ++v) { const int m = 16 * mt + 4 * fq + v; const int df = n - m; s[mt][v] = (df >= 0) ? s[mt][v] * 0.125f * fexp2((float)df * lg) : 0.f; } } }
    f32x4 o1[4], o2[4];
#pragma unroll
    for (int et = 0; et < 4; ++et) { o1[et] = (f32x4){0.f, 0.f, 0.f, 0.f}; o2[et] = (f32x4){0.f, 0.f, 0.f, 0.f}; }
#pragma unroll
    for (int pg = 0; pg < 4; ++pg) if (2 * pg <= w) { const bf16x8 pb = mk8(pk(s[2 * pg][0], s[2 * pg][1]), pk(s[2 * pg][2], s[2 * pg][3]), pk(s[2 * pg + 1][0], s[2 * pg + 1][1]), pk(s[2 * pg + 1][2], s[2 * pg + 1][3]));
#pragma unroll
        for (int et = 0; et < 4; ++et) o1[et] = MFMA16(tr_frag(VI, pg, et, fr, fq), pb, o1[et]); }
#pragma unroll
    for (int ks = 0; ks < 2; ++ks)
#pragma unroll
        for (int et = 0; et < 4; ++et) { const bf16x8 a = *(const LAS bf16x8*)(ST + (16 * et + fr) * 72 + 32 * ks + 8 * fq); o2[et] = MFMA16(a, q[ks], o2[et]); }
    const float xi = fexp2((float)(n + 1) * lg);
    float sum = 0.f;
#pragma unroll
    for (int et = 0; et < 4; ++et) { o1[et] = o1[et] + o2[et] * xi; sum += (o1[et][0] + o1[et][1]) + (o1[et][2] + o1[et][3]); }
    sum += __shfl_xor(sum, 16); sum += __shfl_xor(sum, 32);
    const float mu = sum * (1.f / 64.f); float var = 0.f;
#pragma unroll
    for (int et = 0; et < 4; ++et) { o1[et] = o1[et] - mu; var += (o1[et][0] * o1[et][0] + o1[et][1] * o1[et][1]) + (o1[et][2] * o1[et][2] + o1[et][3] * o1[et][3]); }
    var += __shfl_xor(var, 16); var += __shfl_xor(var, 32);
    const float rs = 1.0f / sqrtf(var * (1.f / 64.f) + EPS);
#pragma unroll
    for (int et = 0; et < 4; ++et) { const int e0 = 16 * et + 4 * fq; const f32x4 gg = *(const f32x4*)(gn + h * 64 + e0); const u32x2 gr = gsave[et];
        const float y0 = o1[et][0] * rs * gg[0] * siluf_(bflo(gr.x)), y1 = o1[et][1] * rs * gg[1] * siluf_(bfhi(gr.x)), y2 = o1[et][2] * rs * gg[2] * siluf_(bflo(gr.y)), y3 = o1[et][3] * rs * gg[3] * siluf_(bfhi(gr.y));
        u32x2 wv; wv.x = pk(y0, y1); wv.y = pk(y2, y3); *(u32x2*)(AR + (row0 + n) * D + 512 + h * 64 + e0) = wv; }
    return nq - F.G;
}

namespace nsa {
constexpr int KP = 128, STG = 2 * 64 * KP, NSTG = 4;
constexpr int OFF_IMPA = NSTG * STG, OFF_IMPB = OFF_IMPA + 32768, OFF_SEL = OFF_IMPB + 32768, OFF_WU = OFF_SEL + 1024, NEED = OFF_WU + 128;
static_assert(NEED <= GTAB_OFF + 16384, "nsa lds");
constexpr float THR = 6.0f;
struct Ctx { LAS unsigned char* lds; const bf16* Z; const bf16* KCMP; const bf16* VCMPT; int tid, lane, wave, fr, fq, b, g, bg, cur; size_t tb; };
typedef unsigned long long u64;
struct M128 { u64 lo, hi; };
DI bool get_bit(const M128& w, int i) { const u64 x = (i < 64) ? w.lo : w.hi; return ((x >> (i & 63)) & 1ull) != 0ull; }
DI void set_bit(M128& w, int i) { const u64 b = 1ull << (i & 63); if (i < 64) w.lo |= b; else w.hi |= b; }
DI int last_bit(const M128& w, int upto) {
    if (upto < 0) return -1;
    u64 x = (upto >= 64) ? (w.hi & (~0ull >> (63 - (upto & 63)))) : 0ull;
    if (x) return 127 - __builtin_clzll(x);
    x = (upto >= 64) ? w.lo : (w.lo & (~0ull >> (63 - upto)));
    if (x) return 63 - __builtin_clzll(x);
    return -1;
}
typedef short s16x4 __attribute__((ext_vector_type(4)));
DI s16x4 vtr(const LAS unsigned char* p) { return __builtin_bit_cast(s16x4, __builtin_amdgcn_ds_read_tr16_b64_v4i16((LAS s16x4*)p)); }
DI float xq_max(float v) { auto a = __builtin_amdgcn_permlane16_swap(__float_as_uint(v), __float_as_uint(v), false, false); v = fmaxf(__uint_as_float(a[0]), __uint_as_float(a[1]));
    auto b = __builtin_amdgcn_permlane32_swap(__float_as_uint(v), __float_as_uint(v), false, false); return fmaxf(__uint_as_float(b[0]), __uint_as_float(b[1])); }
DI float xq_sum(float v) { auto a = __builtin_amdgcn_permlane16_swap(__float_as_uint(v), __float_as_uint(v), false, false); v = __uint_as_float(a[0]) + __uint_as_float(a[1]);
    auto b = __builtin_amdgcn_permlane32_swap(__float_as_uint(v), __float_as_uint(v), false, false); return __uint_as_float(b[0]) + __uint_as_float(b[1]); }
DI float quad_sum(float v) { v += __int_as_float(__builtin_amdgcn_mov_dpp(__float_as_int(v), 0xB1, 0xf, 0xf, true)); v += __int_as_float(__builtin_amdgcn_mov_dpp(__float_as_int(v), 0x4E, 0xf, 0xf, true)); return v; }
DI void glds16(const void* gsrc, unsigned lds_dst) { unsigned keep;
    asm volatile("s_mov_b32 %0, m0\n\ts_mov_b32 m0, %2\n\ts_nop 0\n\tglobal_load_lds_dwordx4 %1, off\n\ts_mov_b32 m0, %0" : "=&s"(keep) : "v"(gsrc), "s"(lds_dst) : "memory"); }
template <int MODE> DI void src_ptrs(const Ctx& X, int m, const char*& kp, size_t& kpitch, const char*& vp) {
    if (MODE <= 1) { kp = (const char*)(X.KCMP + ((size_t)X.bg * 512 + 64 * m) * 64); kpitch = 128; vp = (const char*)(X.VCMPT + ((size_t)X.bg * 512 + 64 * m) * 64); }
    else if (MODE == 2) { kp = (const char*)(X.Z + (X.tb + 64 * m) * ZP + Z_KS + 64 * X.g); kpitch = (size_t)ZP * 2; vp = (const char*)(X.Z + (X.tb + 64 * m) * ZP + Z_VS + 64 * X.g); }
    else { kp = (const char*)(X.Z + (X.tb + 64 * m) * ZP + Z_KW + 64 * X.g); kpitch = (size_t)ZP * 2; vp = (const char*)(X.Z + (X.tb + 64 * m) * ZP + Z_VW + 64 * X.g); }
}
template <int MODE, bool MASKED>
DI void cg_block(const bf16x8 (&kf)[4][2], const bf16x8 (&q)[2], const f32x4& base0, float sl2, float kpos0, int fq4, int lim, bool inv, bool selbit,
                 float& mr, float& lr, f32x4 (&o)[4], bf16x8 (&pb)[2], LAS float* impA, LAS float* impB, int mg0, bool impw, int fr, int fq) {
    const bool use = (MODE == 2) ? selbit : true;
    const float kstep = sl2 * ((MODE <= 1) ? 256.f : 16.f);
    const float blk = use ? (sl2 * kpos0 - mr) : -__builtin_inff();
    f32x4 s[4];
#pragma unroll
    for (int kt = 0; kt < 4; ++kt) { s[kt] = base0 + (blk + kstep * (float)kt);
        if (MASKED) {
#pragma unroll
            for (int v = 0; v < 4; ++v) s[kt][v] = (((16 * kt + fq4 + v) <= lim) != inv) ? s[kt][v] : -__builtin_inff(); }
#pragma unroll
        for (int ks = 0; ks < 2; ++ks) s[kt] = MFMA16(kf[kt][ks], q[ks], s[kt]); }
    f32x2 ps2 = {0.f, 0.f};
#pragma unroll
    for (int kt = 0; kt < 4; ++kt) {
#pragma unroll
        for (int v = 0; v < 4; ++v) s[kt][v] = fexp2(s[kt][v]);
        ps2 = ps2 + (f32x2){s[kt][0], s[kt][1]} + (f32x2){s[kt][2], s[kt][3]};
        if (MODE == 1) { const float A = quad_sum((s[kt][0] + s[kt][1]) + (s[kt][2] + s[kt][3])), B = quad_sum(s[kt][3]);
            if (impw) { impA[mg0 + 4 * kt] = A; if ((mg0 & 127) + 4 * kt + 1 < 128) impB[mg0 + 4 * kt + 1] = B; } } }
    if (MODE != 1) lr += ps2.x + ps2.y;
    if (MODE != 0) {
#pragma unroll
        for (int kg = 0; kg < 2; ++kg) pb[kg] = mk8(pk(s[2 * kg][0], s[2 * kg][1]), pk(s[2 * kg][2], s[2 * kg][3]), pk(s[2 * kg + 1][0], s[2 * kg + 1][1]), pk(s[2 * kg + 1][2], s[2 * kg + 1][3])); }
}
template <int MODE> DI bool blk_masked(int m, int cur) { return (MODE <= 1) ? (64 * m + 63 > 4 * cur - 2) : (MODE == 2 ? (m == cur) : (m == cur || m == cur - 8)); }
template <int MODE>
DI void do_block(const Ctx& X, int m, int st, const bf16x8 (&q)[2][2], const int (&tq)[2], float sl2, const f32x4& base, int xfr, int xfq,
                 float (&mr)[2], float (&lr)[2], f32x4 (&o)[2][4], const M128& cgU0, const M128& cgU1, const M128& selw0, const M128& selw1) {
    const int cur = X.cur, fq4 = 4 * xfq;
    LAS float* impA = (LAS float*)(X.lds + OFF_IMPA); LAS float* impB = (LAS float*)(X.lds + OFF_IMPB);
    const bool needw = (MODE == 2) ? (get_bit(cgU0, m) || get_bit(cgU1, m)) : true;
    if (!needw) return;
    const LAS unsigned char* Kl = X.lds + st * STG; const LAS unsigned char* Vl = Kl + 64 * KP;
    const bool inv = (MODE == 3) && (m == cur - 8);
    const float kpos0 = (MODE <= 1) ? (float)(1024 * m + 31) : (float)(64 * m);
    const bool masked = blk_masked<MODE>(m, cur);
    bf16x8 kf[4][2];
#pragma unroll
    for (int kt = 0; kt < 4; ++kt)
#pragma unroll
        for (int ks = 0; ks < 2; ++ks) kf[kt][ks] = *(const LAS bf16x8*)(Kl + (16 * kt + xfr) * KP + (((4 * ks + xfq) ^ ((xfr >> 1) & 7)) << 4));
    bf16x8 pb[2][2];
#pragma unroll
    for (int cg = 0; cg < 2; ++cg) {
        const int lim = (MODE <= 1) ? (((tq[cg] - 31) >> 4) - 64 * m) : (tq[cg] - 64 * cur);
        const bool selbit = (MODE == 2) ? get_bit(cg == 0 ? selw0 : selw1, m) : true;
        const int tokl = 8 * X.wave + 4 * cg + (xfr >> 2); const int mg0 = tokl * 128 + 16 * m + xfq; const bool impw = (xfr & 3) == 0;
        if (masked) cg_block<MODE, true>(kf, q[cg], base, sl2, kpos0, fq4, lim, inv, selbit, mr[cg], lr[cg], o[cg], pb[cg], impA, impB, mg0, impw, xfr, xfq);
        else cg_block<MODE, false>(kf, q[cg], base, sl2, kpos0, fq4, lim, inv, selbit, mr[cg], lr[cg], o[cg], pb[cg], impA, impB, mg0, impw, xfr, xfq);
    }
    if (MODE != 0) {
#pragma unroll
        for (int kg = 0; kg < 2; ++kg)
#pragma unroll
            for (int dt = 0; dt < 4; ++dt) {
                const LAS unsigned char* vp0 = Vl + (4 * xfq + (xfr >> 2)) * KP + kg * 4096 + ((dt ^ ((2 * (xfq & 1) + (xfr >> 3)) & 3)) << 5) + ((xfr & 3) << 3);
                const s16x4 lo = vtr(vp0), hi = vtr(vp0 + 2048);
                const bf16x8 a = (bf16x8){lo[0], lo[1], lo[2], lo[3], hi[0], hi[1], hi[2], hi[3]};
                o[0][dt] = MFMA16(a, pb[0][kg], o[0][dt]); o[1][dt] = MFMA16(a, pb[1][kg], o[1][dt]); } }
}
template <int MODE> DI void dma_blk(const Ctx& X, int m, int stg, int ln) {
    const char* kp; size_t kpitch; const char* vp; src_ptrs<MODE>(X, m, kp, kpitch, vp);
    const int drow = 8 * X.wave + (ln >> 3), dch = ((ln & 7) ^ ((drow >> 1) & 7)) << 4;
    const unsigned lds0 = (unsigned)(uintptr_t)X.lds + (unsigned)X.wave * 1024u + (unsigned)stg * STG;
    glds16(kp + (unsigned)(drow * ((MODE <= 1) ? 128 : ZP * 2) + dch), (unsigned)__builtin_amdgcn_readfirstlane(lds0));
    const int dchv = ((ln & 7) ^ (2 * ((drow >> 1) & 3))) << 4;
    glds16(vp + (unsigned)(drow * ((MODE <= 1) ? 128 : ZP * 2) + dchv), (unsigned)__builtin_amdgcn_readfirstlane(lds0 + 8192u));
}
template <int MODE, int NMODE>
DI void run_blocks(const Ctx& X, const Ctx& XN, const M128& bm, const bf16x8 (&q)[2][2], const int (&tq)[2], float sl2, float (&mr)[2], float (&lr)[2], f32x4 (&o)[2][4],
                   const M128& cgU0, const M128& cgU1, const M128& selw0, const M128& selw1, int& hb, bool pre, int p0, int p1) {
    int ln_ = X.lane; asm volatile("" : "+v"(ln_));
    const int xfr = ln_ & 15, xfq = ln_ >> 4, fq4 = 4 * xfq;
    f32x4 base;
#pragma unroll
    for (int v = 0; v < 4; ++v) base[v] = sl2 * ((MODE <= 1) ? 16.f : 1.f) * (float)(fq4 + v);
    int m0 = last_bit(bm, 127), m1 = last_bit(bm, m0 - 1);
    while (m0 >= 0) {
        const int n0 = (m1 >= 0) ? last_bit(bm, m1 - 1) : -1, n1 = last_bit(bm, n0 - 1);
        asm volatile("s_waitcnt vmcnt(0) lgkmcnt(0)\n\ts_barrier" ::: "memory");
        if (n0 >= 0) { dma_blk<MODE>(X, n0, 2 * (hb ^ 1), ln_); if (n1 >= 0) dma_blk<MODE>(X, n1, 2 * (hb ^ 1) + 1, ln_); }
        else if (pre) { dma_blk<NMODE>(XN, p0, 2 * (hb ^ 1), ln_); if (p1 >= 0) dma_blk<NMODE>(XN, p1, 2 * (hb ^ 1) + 1, ln_); }
        do_block<MODE>(X, m0, 2 * hb, q, tq, sl2, base, xfr, xfq, mr, lr, o, cgU0, cgU1, selw0, selw1);
        if (m1 >= 0) do_block<MODE>(X, m1, 2 * hb + 1, q, tq, sl2, base, xfr, xfq, mr, lr, o, cgU0, cgU1, selw0, selw1);
        if (MODE != 1) {
#pragma unroll
            for (int cg = 0; cg < 2; ++cg) if (__any(lr[cg] > 0x1p60f)) { mr[cg] += 64.f; lr[cg] *= 0x1p-64f;
                if (MODE != 0) {
#pragma unroll
                    for (int dt = 0; dt < 4; ++dt) o[cg][dt] = o[cg][dt] * 0x1p-64f; } } }
        m0 = n0; m1 = n1; hb ^= 1;
    }
}
DI void make_ctx(Ctx& X, Frame& F, const bf16* Z, const bf16* KCMP, const bf16* VCMPT, int u) {
    X.lds = F.lds; X.Z = Z; X.KCMP = KCMP; X.VCMPT = VCMPT; X.tid = F.tid; X.lane = F.lane; X.wave = F.wave; X.fr = F.lane & 15; X.fq = F.lane >> 4;
    X.bg = u & 15; X.b = X.bg >> 1; X.g = X.bg & 1; X.cur = 127 - (u >> 4); X.tb = (size_t)X.b * SEQ;
}
constexpr int NQ = 2048;
DI int unit(Frame& F, const bf16* Z, const bf16* KCMP, const bf16* VCMPT, bf16* AR, int u, int& hb, unsigned* qctr, LAS int* qslot) {
    Ctx X, XN; make_ctx(X, F, Z, KCMP, VCMPT, u);
    int grabbed = 0; if (F.tid == 0) grabbed = (int)__hip_atomic_fetch_add(qctr, 1u, __ATOMIC_RELAXED, __HIP_MEMORY_SCOPE_AGENT);
    const int cur = X.cur, t0 = 64 * cur, r = X.fr & 3, head = 4 * X.g + r;
    const float sl2 = exp2f(-(float)(head + 1)) * LOG2E;
    int tq[2]; bf16x8 q[2][2]; float gate[2][3];
#pragma unroll
    for (int cg = 0; cg < 2; ++cg) { tq[cg] = t0 + 8 * X.wave + 4 * cg + (X.fr >> 2); const bf16* zr = Z + (X.tb + tq[cg]) * ZP;
#pragma unroll
        for (int ks = 0; ks < 2; ++ks) { const u32x4 w = *(const u32x4*)(zr + Z_QN + head * 64 + 32 * ks + 8 * X.fq); constexpr float C1 = 0.125f * LOG2E;
            q[cg][ks] = mk8(pk(bflo(w.x) * C1, bfhi(w.x) * C1), pk(bflo(w.y) * C1, bfhi(w.y) * C1), pk(bflo(w.z) * C1, bfhi(w.z) * C1), pk(bflo(w.w) * C1, bfhi(w.w) * C1)); }
#pragma unroll
        for (int br = 0; br < 3; ++br) gate[cg][br] = sigmoidf_(bf2f(zr[Z_GL + br * 8 + head])); }
    __builtin_amdgcn_s_waitcnt(0);
    f32x4 o[2][4]; float mr[2], lr[2];
    LAS f32x4* FIN = (LAS f32x4*)(X.lds + OFF_IMPA + X.wave * 8192) + X.lane;
    M128 cgU0 = {0ull, 0ull}, cgU1 = {0ull, 0ull}, selw0 = {0ull, 0ull}, selw1 = {0ull, 0ull}, bm;
    { const int jmax = (4 * cur + 2) >> 6; bm.lo = (2ull << jmax) - 1ull; bm.hi = 0ull; }
#pragma unroll
    for (int cg = 0; cg < 2; ++cg) { mr[cg] = sl2 * (float)tq[cg]; lr[cg] = 0.f;
#pragma unroll
        for (int dt = 0; dt < 4; ++dt) o[cg][dt] = (f32x4){0.f, 0.f, 0.f, 0.f}; }
    const int jm = (4 * cur + 2) >> 6;
    run_blocks<0, 1>(X, X, bm, q, tq, sl2, mr, lr, o, cgU0, cgU1, selw0, selw1, hb, true, jm, jm - 1);
#pragma unroll
    for (int cg = 0; cg < 2; ++cg) { const float lt = xq_sum(lr[cg]); mr[cg] = lt > 0.f ? mr[cg] + log2f(lt) : __builtin_inff(); }
    run_blocks<1, 2>(X, X, bm, q, tq, sl2, mr, lr, o, cgU0, cgU1, selw0, selw1, hb, true, cur, cur - 1);
#pragma unroll
    for (int cg = 0; cg < 2; ++cg)
#pragma unroll
        for (int dt = 0; dt < 4; ++dt) o[cg][dt] = o[cg][dt] * gate[cg][0];
    asm volatile("s_waitcnt lgkmcnt(0)" ::: "memory");
    {
        const LAS float* IA = (const LAS float*)(X.lds + OFF_IMPA); const LAS float* IB = (const LAS float*)(X.lds + OFF_IMPB); LAS u64* SEL = (LAS u64*)(X.lds + OFF_SEL);
        const int nforced = cur == 0 ? 1 : (cur == 1 ? 2 : 3), KK = 16 - nforced, ncand = cur - 2 > 0 ? cur - 2 : 0;
        M128 forced = {1ull, 0ull}; set_bit(forced, cur); if (cur >= 1) set_bit(forced, cur - 1);
        const int m0 = X.lane, m1 = X.lane + 64; const bool c0 = (m0 >= 1 && m0 <= cur - 2), c1 = (m1 <= cur - 2);
        M128 wu = {0ull, 0ull};
#pragma unroll 4
        for (int ti = 0; ti < 8; ++ti) { const int tok = 8 * X.wave + ti;
            const unsigned k0 = c0 ? (__float_as_uint(IA[tok * 128 + m0] + IB[tok * 128 + m0]) + 1u) : 0u, k1 = c1 ? (__float_as_uint(IA[tok * 128 + m1] + IB[tok * 128 + m1]) + 1u) : 0u;
            bool s0 = c0, s1 = c1;
            if (ncand > KK) { unsigned thr = 0u;
                for (int bit = 30; bit >= 0; --bit) { const unsigned cand = thr | (1u << bit); const int cnt = __popcll(__ballot(k0 >= cand)) + __popcll(__ballot(k1 >= cand)); if (cnt >= KK) { thr = cand; if (cnt == KK) break; } }
                const u64 g0 = __ballot(k0 > thr), g1 = __ballot(k1 > thr), e0 = __ballot(k0 == thr && c0), e1 = __ballot(k1 == thr && c1);
                const int needn = KK - (__popcll(g0) + __popcll(g1)); const u64 lt = (1ull << X.lane) - 1ull;
                const int rk0 = __popcll(e0 & lt), rk1 = __popcll(e0) + __popcll(e1 & lt);
                s0 = (k0 > thr) || (k0 == thr && c0 && rk0 < needn); s1 = (k1 > thr) || (k1 == thr && c1 && rk1 < needn); }
            const u64 wlo = __ballot(s0) | forced.lo, whi = __ballot(s1) | forced.hi;
            if (X.lane == 0) { SEL[tok * 2] = wlo; SEL[tok * 2 + 1] = whi; }
            if (ti < 4) { cgU0.lo |= wlo; cgU0.hi |= whi; } else { cgU1.lo |= wlo; cgU1.hi |= whi; }
            wu.lo |= wlo; wu.hi |= whi; }
        if (X.lane == 0) { ((LAS u64*)(X.lds + OFF_WU))[X.wave * 2] = wu.lo; ((LAS u64*)(X.lds + OFF_WU))[X.wave * 2 + 1] = wu.hi; }
        asm volatile("s_waitcnt lgkmcnt(0)" ::: "memory");
        { const int tl0 = 8 * X.wave + (X.fr >> 2), tl1 = tl0 + 4; selw0.lo = SEL[tl0 * 2]; selw0.hi = SEL[tl0 * 2 + 1]; selw1.lo = SEL[tl1 * 2]; selw1.hi = SEL[tl1 * 2 + 1]; }
        if (F.tid == 0) qslot[0] = grabbed;
        __syncthreads();
        #pragma unroll
        for (int cg = 0; cg < 2; ++cg)
#pragma unroll
            for (int dt = 0; dt < 4; ++dt) FIN[(cg * 4 + dt) * 64] = o[cg][dt];
        bm.lo = 0ull; bm.hi = 0ull;
#pragma unroll
        for (int w = 0; w < 8; ++w) { bm.lo |= ((const LAS u64*)(X.lds + OFF_WU))[w * 2]; bm.hi |= ((const LAS u64*)(X.lds + OFF_WU))[w * 2 + 1]; }
        bm.lo = ((u64)__builtin_amdgcn_readfirstlane((unsigned)(bm.lo >> 32)) << 32) | (u64)__builtin_amdgcn_readfirstlane((unsigned)bm.lo);
        bm.hi = ((u64)__builtin_amdgcn_readfirstlane((unsigned)(bm.hi >> 32)) << 32) | (u64)__builtin_amdgcn_readfirstlane((unsigned)bm.hi);
    }
    const int un = F.G + __builtin_amdgcn_readfirstlane(qslot[0]);
    make_ctx(XN, F, Z, KCMP, VCMPT, un < NQ ? un : u);
#pragma unroll
    for (int cg = 0; cg < 2; ++cg) { mr[cg] = sl2 * (float)tq[cg]; lr[cg] = 0.f;
#pragma unroll
        for (int dt = 0; dt < 4; ++dt) o[cg][dt] = (f32x4){0.f, 0.f, 0.f, 0.f}; }
    run_blocks<2, 3>(X, X, bm, q, tq, sl2, mr, lr, o, cgU0, cgU1, selw0, selw1, hb, true, cur, cur - 1);
#pragma unroll
    for (int cg = 0; cg < 2; ++cg) { const float lt = xq_sum(lr[cg]); const float sc = (lt > 0.f ? 1.0f / lt : 0.f) * gate[cg][1];
#pragma unroll
        for (int dt = 0; dt < 4; ++dt) FIN[(cg * 4 + dt) * 64] = FIN[(cg * 4 + dt) * 64] + o[cg][dt] * sc; }
    bm.lo = 0ull; bm.hi = 0ull;
    for (int mm = (cur >= 8 ? cur - 8 : 0); mm <= cur; ++mm) set_bit(bm, mm);
#pragma unroll
    for (int cg = 0; cg < 2; ++cg) { mr[cg] = sl2 * (float)tq[cg]; lr[cg] = 0.f;
#pragma unroll
        for (int dt = 0; dt < 4; ++dt) o[cg][dt] = (f32x4){0.f, 0.f, 0.f, 0.f}; }
    { const int jn = (4 * XN.cur + 2) >> 6; run_blocks<3, 0>(X, XN, bm, q, tq, sl2, mr, lr, o, cgU0, cgU1, selw0, selw1, hb, un < NQ, jn, jn - 1); }
#pragma unroll
    for (int cg = 0; cg < 2; ++cg) { const float lt = xq_sum(lr[cg]); const float sc = (lt > 0.f ? 1.0f / lt : 0.f) * gate[cg][2];
        bf16* orow = AR + (X.tb + tq[cg]) * D + head * 64;
#pragma unroll
        for (int dt = 0; dt < 4; ++dt) { const f32x4 y = FIN[(cg * 4 + dt) * 64] + o[cg][dt] * sc; u32x2 wv; wv.x = pk(y[0], y[1]); wv.y = pk(y[2], y[3]); *(u32x2*)(orow + 16 * dt + 4 * X.fq) = wv; } }
    return un - F.G;
}
}

__global__ void __launch_bounds__(NTHR, 2) hybrid_fwd(Args args) {
    extern __shared__ __attribute__((aligned(16))) unsigned char lds_raw[];
    Frame F; F.lds = (LAS unsigned char*)lds_raw; F.ws = args.ws; F.tid = threadIdx.x; F.lane = F.tid & 63; F.wave = __builtin_amdgcn_readfirstlane(F.tid >> 6); F.wave0 = F.wave; F.G = gridDim.x; F.bid = blockIdx.x;
    volatile LAS unsigned* MISC = (volatile LAS unsigned*)(F.lds + MISC_OFF);
    if (F.tid < 32) MISC[F.tid] = 0u;
    __syncthreads();
    unsigned* ctl = (unsigned*)(args.ws + WS_CTL);
    XcdBarrier bar = xcd_barrier_post(ctl + 4096, MISC + 8, F.wave0);
    unsigned char* ws = args.ws;
#define RELAUNDER() do { relaunder(F); GAS unsigned char* wsg_ = (GAS unsigned char*)ws; asm volatile("" : "+s"(wsg_)); ws = (unsigned char*)wsg_; F.ws = ws; } while (0)
#define P16 ((bf16*)args.out)
#define Q16 (((bf16*)args.out) + (size_t)T * D)
#define H16C ((bf16*)(ws + WS_Z + 128 * MiB))
#define HL (L == 0 ? P16 : Q16)
#define Zb ((bf16*)(ws + WS_Z))
#define AR ((bf16*)(ws + WS_AR))
#define RETS ((float*)(ws + WS_RETS))
#define VST ((bf16*)(ws + WS_VST))
#define VWT ((bf16*)(ws + WS_VWT))
#define HIDC ((bf16*)(ws + WS_HIDC))
#define KCMP ((bf16*)(ws + WS_KCMP))
#define VCMPT ((bf16*)(ws + WS_VCMPT))
#define POSB ((float*)(ws + WS_POSB))
#define BCNT ((int*)(ws + WS_BCNT))
#define META ((int*)(ws + WS_META))
#define TOKINFO ((float*)(ws + WS_TOKINFO))
#define TOKROW ((int*)(ws + WS_TOKROW))
#define ROWTOK ((int*)(ws + WS_ROWTOK))
#define RSTD ((float*)(ws + WS_RSTD))
#define SSA ((float*)(ws + WS_SSA))
#define SSB ((float*)(ws + WS_SSB))
#define HID8 ((unsigned char*)(ws + WS_HID))
#define H8 ((unsigned char*)(ws + WS_XN))
#define YP ((bf16*)(ws + WS_YP))
#define YP8 ((unsigned char*)(ws + WS_YP))
#define PP ((bf16*)(ws + WS_PP))
#define SIG8 ((unsigned char*)(ws + WS_PP))
#define PBALL ((bf16*)(ws + WS_PBALL))
    const LAS int* gtab = (const LAS int*)(F.lds + GTAB_OFF); LAS int* uinfo = (LAS int*)(F.lds + UINFO_OFF);
    LAS float* rtab = (LAS float*)(F.lds + RTAB_OFF);

    PH(0) {
        LAS float* scr = (LAS float*)(F.lds + F.wave * 16384);
        const int gw = F.bid * NWAVES + F.wave, NGW = F.G * NWAVES;
        for (int s = 0; s < NSEG; ++s) { const Seg g = seg_decode(args, s); const int nit = (g.K / 64) * (g.ncols / 32);
            for (int it = gw; it < nit; it += 2 * NGW) { f32x4 r0[8], r1[8]; const int it1 = it + NGW; transpose_load(g, it, F.lane, r0); if (it1 < nit) transpose_load(g, it1, F.lane, r1);
                transpose_store(g, scr, it, F.lane, r0); if (it1 < nit) transpose_store(g, scr, it1, F.lane, r1); } }
        __syncthreads();
        if (F.bid < 32) { const int hl = F.tid & 31, kg = F.tid >> 5, oi = F.bid * 32 + hl, lw = oi >> 8, hcol = oi & 255;
            const float* pos = args.in[I_CPOS] + (size_t)lw * 2048 + kg * 128; const float* w1 = args.in[I_CW1] + (size_t)lw * 2048 * 256 + (size_t)kg * 128 * 256 + hcol; float a = 0.f;
#pragma unroll 8
            for (int k = 0; k < 128; ++k) a += pos[k] * w1[(size_t)k * 256];
            LAS float* red = (LAS float*)F.lds; red[kg * 32 + hl] = a; __syncthreads();
            if (F.tid < 32) { float t = 0.f;
#pragma unroll
                for (int j = 0; j < 16; ++j) t += red[j * 32 + F.tid]; POSB[F.bid * 32 + F.tid] = t; }
            __syncthreads(); }
        norm_first(F, args.in[I_X], P16, RSTD);
        pb_convert(F, args.in[I_P], PBALL);
    }
    xcd_barrier(bar, F.wave0); RELAUNDER();

    for (int L = 0; L < 2; ++L) {
        unsigned char* wl = ws + WS_W + (size_t)L * WL_STRIDE;
        PH(1) {
          if (F8_IN1 && L == 1) { pg8::Gemm g{(const bf16*)H8, (const bf16*)(wl + WL_WIN), D / 2, D / 2, 128}; pg8::StaticOrder S; S.init(T / 256, ZP / 256, F.G, F.bid, (size_t)256 * D, (size_t)256 * D);
            pg8::EpiBf16<0, ST_MODE> E{Zb, ZP, nullptr, 0, 1.0f / (S8_H * S8_WU), IN_COLS}; fill_rtab<true>(F, S, rtab, SSA);
            pg8::gemm_phase<pg8::EpiBf16<0, ST_MODE>, pg8::StaticOrder, false, 1, true>(F.tid, F.lds, g, S, E, gtab, rtab); }
          else { pg8::Gemm g{HL, (const bf16*)(wl + WL_WIN), D, D, 128}; pg8::StaticOrder S; S.init(T / 256, ZP / 256, F.G, F.bid, (size_t)256 * D * 2, (size_t)256 * D * 2);
            pg8::EpiBf16<0, ST_MODE> E{Zb, ZP, nullptr, 0, 1.0f, IN_COLS};
            if (L == 0) fill_rtab<false>(F, S, rtab, RSTD); else fill_rtab<true>(F, S, rtab, SSA);
            pg8::gemm_phase<pg8::EpiBf16<0, ST_MODE>, pg8::StaticOrder, false, 1>(F.tid, F.lds, g, S, E, gtab, rtab); } }
        xcd_barrier(bar, F.wave0); RELAUNDER();
        PH(2) { pg8::Gemm g{Zb, (const bf16*)(wl + WL_CW1), 2048, 16 * ZP, ZP * 2}; pg8::CmpOrder S{F.G, F.bid};
          pg8::EpiBf16<2> E{HIDC, 256, POSB + L * 512, 5}; pg8::gemm_phase<pg8::EpiBf16<2>, pg8::CmpOrder, false>(F.tid, F.lds, g, S, E, gtab); }
        __syncthreads();
        PH(4) {
          if (F.G == 256) { const int w = F.bid - 64; ret_kv_units(F, Zb, RETS, w * 21 + (w < 64 ? w : 64), 1, w < 0 ? 0 : 21 + (w < 64 ? 1 : 0)); }
          else ret_kv_units(F, Zb, RETS, F.bid, F.G, (4096 - F.bid + F.G - 1) / F.G); }
        xcd_barrier(bar, F.wave0); RELAUNDER();
        PH(5) cmp_out(F, HIDC, args.in[I_CW2] + (size_t)L * 2 * 256 * 64, KCMP, VCMPT);
        PH(6) ret_scan(F, RETS);
        xcd_barrier(bar, F.wave0); RELAUNDER();
        {
          int hb = 0; unsigned* qctr = ctl + 8192 + 64 * L; LAS int* qslot = (LAS int*)(F.lds + MISC_OFF) + 16; int u = F.bid; const float* gnp = args.in[I_RETGN] + (size_t)L * 512;
          if (u < nsa::NQ) { nsa::Ctx X0; nsa::make_ctx(X0, F, Zb, KCMP, VCMPT, u); const int jm = (4 * X0.cur + 2) >> 6; nsa::dma_blk<0>(X0, jm, 0, F.lane); if (jm >= 1) nsa::dma_blk<0>(X0, jm - 1, 1, F.lane); }
#pragma nounroll
          while (u < nsa::NQ) u = F.G + nsa::unit(F, Zb, KCMP, VCMPT, AR, u, hb, qctr, qslot);
          __syncthreads();
          if (u < nsa::NQ + 4096) ret_out_dma(F, Zb, RETS, u - nsa::NQ, 0);
          int kb = 0;
#pragma nounroll
          while (u < nsa::NQ + 4096) { u = F.G + ret_out_unit(F, Zb, RETS, gnp, AR, u - nsa::NQ, kb, qctr, qslot); kb ^= 1; }
          __syncthreads(); }
        xcd_barrier(bar, F.wave0); RELAUNDER();
        PH(9) { pg8::Gemm g{AR, (const bf16*)(wl + WL_WOUT), D, D, 128}; pg8::StaticOrder S; S.init(T / 256, D / 256, F.G, F.bid, (size_t)256 * D * 2, (size_t)256 * D * 2);
          if (L == 0) { pg8::EpiRes16<(F8_DUP != 0)> E{P16, P16, SSA, H8, 1.0f}; pg8::gemm_phase<pg8::EpiRes16<(F8_DUP != 0)>, pg8::StaticOrder, false>(F.tid, F.lds, g, S, E, gtab); }
          else { pg8::EpiRes16<true> E{Q16, Q16, SSA, H8, 1.0f}; pg8::gemm_phase<pg8::EpiRes16<true>, pg8::StaticOrder, false>(F.tid, F.lds, g, S, E, gtab); } }
        xcd_barrier(bar, F.wave0); RELAUNDER();
        if (L == 0) {
            constexpr int FCH = 128;
            for (int ch = 0; ch < (T / 256) / FCH; ++ch) {
                PH(11) {
#if F8_DUP
                  pg8::Gemm g{(const bf16*)H8, (const bf16*)(ws + WS_WDENSE), D / 2, D / 2, 128}; pg8::StaticOrder S; S.init(FCH, 2 * DFF / 256, F.G, F.bid, (size_t)256 * D, (size_t)256 * D, ch * FCH); const float usc = 1.0f / (S8_H * S8_WU);
#else
                  pg8::Gemm g{P16, (const bf16*)(ws + WS_WDENSE), D, D, 128}; pg8::StaticOrder S; S.init(FCH, 2 * DFF / 256, F.G, F.bid, (size_t)256 * D * 2, (size_t)256 * D * 2, ch * FCH); const float usc = 1.0f;
#endif
                  fill_rtab<true>(F, S, rtab, SSA);
#if F8_DDN
                  pg8::EpiSwiGLU E{HID8, 0, usc}; pg8::gemm_phase<pg8::EpiSwiGLU, pg8::StaticOrder, false, 1, F8_DUP != 0>(F.tid, F.lds, g, S, E, gtab, rtab); }
#else
                  pg8::EpiSwiGLU16 E{(bf16*)HID8, 0, usc}; pg8::gemm_phase<pg8::EpiSwiGLU16, pg8::StaticOrder, false, 1, F8_DUP != 0>(F.tid, F.lds, g, S, E, gtab, rtab); }
#endif
                xcd_barrier(bar, F.wave0); RELAUNDER();
#if F8_DDN
                PH(12) { pg8::Gemm g{(const bf16*)HID8, (const bf16*)(ws + WS_WDENSE + 14 * MiB), DFF / 2, DFF / 2, 128}; pg8::StaticOrder S; S.init(FCH, D / 256, F.G, F.bid, (size_t)256 * DFF, (size_t)256 * DFF, ch * FCH);
                  pg8::EpiRes16<(F8_GATE != 0)> E{P16, P16, SSB, H8, 1.0f / (S8_HID * S8_WD)}; pg8::gemm_phase<pg8::EpiRes16<(F8_GATE != 0)>, pg8::StaticOrder, false, 0, true>(F.tid, F.lds, g, S, E, gtab); }
#else
                PH(12) { pg8::Gemm g{(const bf16*)HID8, (const bf16*)(ws + WS_WDENSE + 14 * MiB), DFF, DFF, 128}; pg8::StaticOrder S; S.init(FCH, D / 256, F.G, F.bid, (size_t)256 * DFF * 2, (size_t)256 * DFF * 2, ch * FCH);
                  pg8::EpiRes16<false> E{P16, P16, SSB, nullptr, 1.0f}; pg8::gemm_phase<pg8::EpiRes16<false>, pg8::StaticOrder, false>(F.tid, F.lds, g, S, E, gtab); }
#endif
                RELAUNDER();
            }
        } else {
            PH(14) norm_router(F, Q16, args.in[I_GFFN] + (size_t)L * D, args.in[I_ROUTER], TOKINFO, BCNT);
            xcd_barrier(bar, F.wave0); RELAUNDER();
            PH(15) moe_index(F, BCNT, TOKINFO, TOKROW, ROWTOK, META);
            xcd_barrier(bar, F.wave0); RELAUNDER();
            const int NP = __builtin_amdgcn_readfirstlane(__hip_atomic_load(META, __ATOMIC_RELAXED, __HIP_MEMORY_SCOPE_AGENT));
            const int rp = (NP + MOE_ROUNDS - 1) / MOE_ROUNDS, nrounds = rp > 0 ? (NP + rp - 1) / rp : 0;
            for (int rd = 0; rd < nrounds; ++rd) {
                const int pm0 = rd * rp, npan = (NP - pm0) < rp ? (NP - pm0) : rp;
                PH(16) { pg8::StaticOrder S0; S0.init(npan, 2 * DFF / 256, F.G, F.bid, 0, 0); int n = 0; pg8::Unit u;
                  int nrs = 0, lastpm = -1;
                  for (int i = 0; i < 32 && S0.next(i, u); ++i) { const int pm = pm0 + u.pm; const int ex = META[16 + pm];
                      if (F.tid == 0) { uinfo[4 * i] = pm; uinfo[4 * i + 1] = u.pn; uinfo[4 * i + 2] = ex; }
                      if (pm != lastpm) { if (nrs < 15 && F.tid == 0) uinfo[4 * nrs + 3] = pm; lastpm = pm; ++nrs; }
                      n = i + 1; }
                  __syncthreads();
                  { const int ns = nrs < 15 ? nrs : 15, r = F.tid & 255, s0 = F.tid >> 8; int toks[8];
#pragma unroll
                    for (int j = 0; j < 8; ++j) { const int sl = s0 + 2 * j; toks[j] = (sl < ns) ? ROWTOK[uinfo[4 * sl + 3] * 256 + r] : 0; }
#pragma unroll
                    for (int j = 0; j < 8; ++j) { const int sl = s0 + 2 * j; if (sl < ns) { ((LAS int*)(F.lds + GTAB_OFF))[sl * 256 + r] = toks[j]; rtab[sl * 256 + r] = rstd_from_ss(SSA, toks[j]); } } }
                  __syncthreads();
#if F8_MOE
                  pg8::Gemm g{(const bf16*)H8, (const bf16*)(ws + WS_WMOE), D / 2, D / 2, 128}; pg8::MoeOrder S{uinfo, n, pm0, 0, (size_t)256 * D, WE_STRIDE};
                  pg8::EpiSwiGLU E{HID8, pm0 * 256, 1.0f / (S8_H * S8_WU)}; pg8::gemm_phase<pg8::EpiSwiGLU, pg8::MoeOrder, true, 1, true>(F.tid, F.lds, g, S, E, gtab, rtab); }
#else
                  pg8::Gemm g{Q16, (const bf16*)(ws + WS_WMOE), D, D, 128}; pg8::MoeOrder S{uinfo, n, pm0, 0, (size_t)256 * D * 2, WE_STRIDE};
                  pg8::EpiSwiGLU16 E{(bf16*)HID8, pm0 * 256}; pg8::gemm_phase<pg8::EpiSwiGLU16, pg8::MoeOrder, true, 1>(F.tid, F.lds, g, S, E, gtab, rtab); }
#endif
                xcd_barrier(bar, F.wave0); RELAUNDER();
                PH(17) { pg8::StaticOrder S0; S0.init(npan, D / 256, F.G, F.bid, 0, 0); int n = 0; pg8::Unit u;
                  for (int i = 0; i < 32 && S0.next(i, u); ++i) { const int pm = pm0 + u.pm; const int ex = META[16 + pm];
                      if (F.tid == 0) { uinfo[4 * i] = pm; uinfo[4 * i + 1] = u.pn; uinfo[4 * i + 2] = ex; } n = i + 1; }
                  __syncthreads();
#if F8_MOE
                  pg8::Gemm g{(const bf16*)HID8, (const bf16*)(ws + WS_WMOE + WE_DOWN), DFF / 2, DFF / 2, 128}; pg8::MoeOrder S{uinfo, n, pm0, (size_t)256 * DFF, (size_t)256 * DFF, WE_STRIDE};
                  pg8::EpiOut8 E{YP8, D, S8_Y / (S8_HID * S8_WD)}; pg8::gemm_phase<pg8::EpiOut8, pg8::MoeOrder, false, 0, true>(F.tid, F.lds, g, S, E, gtab); }
#else
                  pg8::Gemm g{(const bf16*)HID8, (const bf16*)(ws + WS_WMOE + WE_DOWN), DFF, DFF, 128}; pg8::MoeOrder S{uinfo, n, pm0, (size_t)256 * DFF * 2, (size_t)256 * DFF * 2, WE_STRIDE};
                  pg8::EpiBf16<0> E{YP, D, nullptr, 0}; pg8::gemm_phase<pg8::EpiBf16<0>, pg8::MoeOrder, false>(F.tid, F.lds, g, S, E, gtab); }
#endif
                xcd_barrier(bar, F.wave0); RELAUNDER();
            }
            PH(18) moe_combine(F, Q16, H8, RSTD, YP8, TOKROW, TOKINFO);
        }
        xcd_barrier(bar, F.wave0); RELAUNDER();
        PH(20) {
#if F8_GATE
          pg8::Gemm g{(const bf16*)H8, (const bf16*)(wl + WL_PGATE), D / 2, D / 2, 128}; pg8::StaticOrder S; S.init(T / 256, D / 256, F.G, F.bid, (size_t)256 * D, (size_t)256 * D);
          if (L == 0) fill_rtab<true>(F, S, rtab, SSB); else fill_rtab<false>(F, S, rtab, RSTD);
          pg8::EpiSig8 E{SIG8, 1.0f / (S8_H * S8_WU)}; pg8::gemm_phase<pg8::EpiSig8, pg8::StaticOrder, false, 1, true>(F.tid, F.lds, g, S, E, gtab, rtab); }
#else
          pg8::Gemm g{HL, (const bf16*)(wl + WL_PGATE), D, D, 128}; pg8::StaticOrder S; S.init(T / 256, D / 256, F.G, F.bid, (size_t)256 * D * 2, (size_t)256 * D * 2);
          if (L == 0) fill_rtab<true>(F, S, rtab, SSB); else fill_rtab<false>(F, S, rtab, RSTD);
          pg8::EpiSig8 E{SIG8}; pg8::gemm_phase<pg8::EpiSig8, pg8::StaticOrder, false, 1>(F.tid, F.lds, g, S, E, gtab, rtab); }
#endif
        __syncthreads();
        PH(19) { pg8::Gemm g{PBALL + (size_t)L * T * PLE, (const bf16*)(wl + WL_PPROJ), PLE, PLE, 128}; pg8::StaticOrder S; S.init(T / 256, D / 256, F.G, F.bid, (size_t)256 * PLE * 2, (size_t)256 * PLE * 2);
          if (L == 0) { pg8::EpiPleApply<true> E{P16, SIG8, Q16, SSA}; pg8::gemm_phase<pg8::EpiPleApply<true>, pg8::StaticOrder, false>(F.tid, F.lds, g, S, E, gtab); }
          else { pg8::EpiPleApply<false> E{Q16, SIG8, H16C, nullptr}; pg8::gemm_phase<pg8::EpiPleApply<false>, pg8::StaticOrder, false>(F.tid, F.lds, g, S, E, gtab); } }
        xcd_barrier(bar, F.wave0); RELAUNDER();
    }
    PH(22) norm_final(F, H16C, args.in[I_GFINAL], args.out);
}

extern "C" void kernel_launch(void* const* d_in, const int* in_sizes, int n_in, void* d_out, int out_size, void* d_ws, size_t ws_size, hipStream_t stream) {
    static int grid = 0;
    if (grid == 0) {
        if (n_in != 21 || out_size != T * D || ws_size < WS_END) { fprintf(stderr, "kernel_launch: unexpected shapes (n_in %d out %d ws %zu)\n", n_in, out_size, ws_size); grid = -1; return; }
        int dev = 0, cus = 0, per_cu = 0;
        if (hipGetDevice(&dev) != hipSuccess || hipDeviceGetAttribute(&cus, hipDeviceAttributeMultiprocessorCount, dev) != hipSuccess) { grid = -1; return; }
        if (hipFuncSetAttribute((const void*)hybrid_fwd, hipFuncAttributeMaxDynamicSharedMemorySize, LDS_BYTES) != hipSuccess) { fprintf(stderr, "kernel_launch: hipFuncSetAttribute failed\n"); grid = -1; return; }
        if (hipOccupancyMaxActiveBlocksPerMultiprocessor(&per_cu, (const void*)hybrid_fwd, NTHR, LDS_BYTES) != hipSuccess || per_cu < 1) fprintf(stderr, "kernel_launch: occupancy query reports %d\n", per_cu);
        (void)hipGetLastError();
        grid = cus;
    }
    if (grid < 0) return;
    if (hipMemsetAsync((char*)d_ws + WS_CTL, 0, CTL_ZERO_BYTES, stream) != hipSuccess) return;
    Args a{};
    for (int i = 0; i < 21; ++i) a.in[i] = (const float*)d_in[i];
    a.out = (float*)d_out; a.ws = (unsigned char*)d_ws;
    hipLaunchKernelGGL(hybrid_fwd, dim3(grid), dim3(NTHR), LDS_BYTES, stream, a);
}
```

```cpp
#include <hip/hip_runtime.h>
#include <cstdio>
#include <cstdint>

#define DI __device__ __forceinline__
#define LAS __attribute__((address_space(3)))
#define GAS __attribute__((address_space(1)))
typedef unsigned short bf16;
typedef short bf16x8 __attribute__((ext_vector_type(8)));
typedef float f32x4 __attribute__((ext_vector_type(4)));
typedef float f32x2 __attribute__((ext_vector_type(2)));
typedef unsigned u32x4 __attribute__((ext_vector_type(4)));
typedef unsigned u32x2 __attribute__((ext_vector_type(2)));
typedef __bf16 bf16x2_t __attribute__((ext_vector_type(2)));

constexpr int NB = 8, SEQ = 8192, T = NB * SEQ, D = 1024, DFF = 3584, NE = 8, PLE = 256;
constexpr int IN_COLS = 3352, ZP = 3584;
constexpr int Z_QN = 0, Z_KC = 512, Z_VC = 640, Z_KS = 768, Z_VS = 896, Z_KW = 1024, Z_VW = 1152, Z_QR = 1280, Z_KR = 1792, Z_VR = 2304, Z_GR = 2816, Z_GL = 3328;
constexpr float EPS = 1e-6f, LOG2E = 1.4426950408889634f;
constexpr int MAXROWS = 2 * T + NE * 256;
constexpr int MOE_ROUNDS = 3, RPANELS_MAX = 174;

constexpr size_t MiB = 1u << 20;
constexpr size_t WS_CTL = 0, CTL_ZERO_BYTES = 1 * MiB;
constexpr size_t WS_POSB = 1 * MiB;
constexpr size_t WS_BCNT = 1 * MiB + 65536;
constexpr size_t WS_META = 1 * MiB + 131072;
constexpr size_t WS_TOKINFO = 2 * MiB;
constexpr size_t WS_TOKROW = 3 * MiB;
constexpr size_t WS_ROWTOK = 4 * MiB;
constexpr size_t WS_RSTD = 5 * MiB;
constexpr size_t WS_SSA = 996 * MiB, WS_SSB = 1000 * MiB;
constexpr size_t WS_PBALL = 932 * MiB;
constexpr size_t WS_W = 6 * MiB;
constexpr size_t WL_STRIDE = 14 * MiB, WL_WIN = 0, WL_WOUT = 7 * MiB, WL_PGATE = 9 * MiB, WL_PPROJ = 11 * MiB, WL_CW1 = 11 * MiB + 512 * 1024;
constexpr size_t WS_WDENSE = WS_W + 2 * WL_STRIDE;
constexpr size_t WS_WMOE = WS_WDENSE + 22 * MiB;
constexpr size_t WE_STRIDE = 21 * MiB, WE_DOWN = 14 * MiB;
constexpr size_t WS_XN = 224 * MiB;
constexpr size_t WS_RETS = WS_XN, WS_VST = WS_XN + 64 * MiB, WS_VWT = WS_XN + 80 * MiB, WS_HIDC = WS_XN + 96 * MiB, WS_KCMP = WS_XN + 104 * MiB, WS_VCMPT = WS_XN + 105 * MiB;
constexpr size_t WS_Z = 352 * MiB;
constexpr size_t WS_HID = WS_Z;
constexpr size_t WS_YP = WS_Z + 306 * MiB;
constexpr size_t WS_PP = WS_Z;
constexpr size_t WS_AR = 800 * MiB;
constexpr size_t WS_END = 1004 * MiB;
static_assert(WS_YP + (size_t)MAXROWS * D * 2 <= WS_PBALL && (size_t)RPANELS_MAX * 256 * DFF * 2 <= 306 * MiB && 3 * RPANELS_MAX >= MAXROWS / 256, "MoE buffers fit");
static_assert(WS_WMOE + NE * WE_STRIDE <= WS_XN, "weights fit");

constexpr int RING_BYTES = 131072;
constexpr int GTAB_OFF = RING_BYTES;
constexpr int RTAB_OFF = GTAB_OFF + 16384;
constexpr int UINFO_OFF = RTAB_OFF + 15360;
constexpr int MISC_OFF = UINFO_OFF + 512;
constexpr int LDS_BYTES = MISC_OFF + 128;
static_assert(LDS_BYTES <= 163840, "LDS");
constexpr int NWAVES = 8, NTHR = 512;
#ifndef PHMASK
#define PHMASK 0xFFFFFFFFu
#endif
#ifndef REPMASK
#define REPMASK 0u
#endif
#define PH(k) if constexpr (((PHMASK) >> (k)) & 1u) for (int rep_ = 0; rep_ < ((((REPMASK) >> (k)) & 1u) ? 2 : 1); ++rep_)

DI unsigned pk(float lo, float hi) { f32x2 v = {lo, hi}; bf16x2_t b = __builtin_convertvector(v, bf16x2_t); return __builtin_bit_cast(unsigned, b); }
DI float bflo(unsigned u) { return __uint_as_float(u << 16); }
DI float bfhi(unsigned u) { return __uint_as_float(u & 0xffff0000u); }
DI float bf2f(bf16 h) { return __uint_as_float(((unsigned)h) << 16); }
typedef int i32x8 __attribute__((ext_vector_type(8)));
typedef int i32x4_t __attribute__((ext_vector_type(4)));
DI unsigned pk8(float a, float b, float c, float d) {
    a = __builtin_fminf(__builtin_fmaxf(a, -448.f), 448.f); b = __builtin_fminf(__builtin_fmaxf(b, -448.f), 448.f); c = __builtin_fminf(__builtin_fmaxf(c, -448.f), 448.f); d = __builtin_fminf(__builtin_fmaxf(d, -448.f), 448.f);
    int w = 0; w = __builtin_amdgcn_cvt_pk_fp8_f32(a, b, w, false); w = __builtin_amdgcn_cvt_pk_fp8_f32(c, d, w, true); return (unsigned)w;
}
#ifndef F8_DENSE
#define F8_DENSE 0
#endif
#ifndef F8_IN1
#define F8_IN1 1
#endif
#ifndef F8_DUP
#define F8_DUP 0
#endif
#ifndef F8_DDN
#define F8_DDN 1
#endif
#ifndef F8_GATE
#define F8_GATE 1
#endif
#ifndef F8_MOE
#define F8_MOE 1
#endif
constexpr float S8_H = 8.f, S8_WU = 32.f, S8_HID = 8.f, S8_WD = 64.f, S8_Y = 16.f;
DI float wave_sum(float v) {
#pragma unroll
    for (int o = 1; o < 64; o <<= 1) v += __shfl_xor(v, o);
    return v;
}
DI float fexp2(float x) { return __builtin_amdgcn_exp2f(x); }
DI float frcp(float x) { return __builtin_amdgcn_rcpf(x); }
DI float sigmoidf_(float x) { return frcp(1.f + fexp2(-x * LOG2E)); }
DI float siluf_(float x) { return x * sigmoidf_(x); }
DI bf16x8 mk8(unsigned a, unsigned b, unsigned c, unsigned d) { u32x4 w = {a, b, c, d}; return __builtin_bit_cast(bf16x8, w); }
#define MFMA16(a, b, c) __builtin_amdgcn_mfma_f32_16x16x32_bf16((a), (b), (c), 0, 0, 0)
typedef short s16x4 __attribute__((ext_vector_type(4)));
DI s16x4 ldtr(const LAS unsigned char* p) { return __builtin_bit_cast(s16x4, __builtin_amdgcn_ds_read_tr16_b64_v4i16((LAS s16x4*)p)); }
DI bf16x8 tr_frag(const LAS unsigned char* img, int kgrp, int ct, int fr, int fq) {
    const LAS unsigned char* p = img + (4 * fq + (fr >> 2)) * 128 + kgrp * 4096 + ((ct ^ ((2 * (fq & 1) + (fr >> 3)) & 3)) << 5) + ((fr & 3) << 3);
    const s16x4 lo = ldtr(p), hi = ldtr(p + 2048); return (bf16x8){lo[0], lo[1], lo[2], lo[3], hi[0], hi[1], hi[2], hi[3]};
}
DI int tr_chunk(int row, int ch) { return ch ^ (2 * ((row >> 1) & 3)); }
DI void gl16(const void* gsrc, unsigned lds_dst) { unsigned keep;
    asm volatile("s_mov_b32 %0, m0\n\ts_mov_b32 m0, %2\n\ts_nop 0\n\tglobal_load_lds_dwordx4 %1, off\n\ts_mov_b32 m0, %0" : "=&s"(keep) : "v"(gsrc), "s"(lds_dst) : "memory"); }

namespace pg8 {
constexpr int BM = 256, BK = 64, HALF = 128, HTB = HALF * BK * 2, STAGE_BYTES = 8 * HTB, NXCD = 8, WGM = 4;
__host__ __device__ __forceinline__ int lds_byte(int r, int c) { const int st = (r >> 4) * 2 + (c >> 5), rr = r & 15, cc = c & 31, ob = rr * 64 + cc * 2; return st * 1024 + (ob ^ (((ob >> 9) & 1) << 5)); }
__host__ __device__ __forceinline__ void stage_rc(int b, int& R, int& C) { const int st = b / 1024, sb = b % 1024, swz = sb ^ (((sb >> 9) & 1) << 5); R = (st >> 1) * 16 + swz / 64; C = (st & 1) * 32 + (swz % 64) / 2; }
__host__ __device__ __forceinline__ int perm32(int rho) { const int n = rho >> 4, i = rho & 15; return 8 * (i >> 2) + 4 * n + (i & 3); }

struct Unit { int pm, pn, ex; };
struct Gemm { const bf16* A; const bf16* Bt; int K; int lda; int kstepA; };

struct StaticOrder {
    int nM, nN, nwg, G, c, pm0; size_t tA, tB;
    DI void init(int nM_, int nN_, int G_, int c_, size_t tA_, size_t tB_, int pm0_ = 0) { nM = nM_; nN = nN_; nwg = nM * nN; G = G_; c = c_; tA = tA_; tB = tB_; pm0 = pm0_; }
    DI bool next(int i, Unit& u) const {
        const long L = (long)i * G + c; if (L >= nwg) return false;
        int wgid = (int)L; { const int q = nwg / NXCD, r = nwg % NXCD, xcd = wgid % NXCD, off = wgid / NXCD; wgid = (xcd < r ? xcd * (q + 1) : r * (q + 1) + (xcd - r) * q) + off; }
        const int nig = WGM * nN, gid = wgid / nig, fm = gid * WGM, gsz = (nM - fm) < WGM ? (nM - fm) : WGM;
        u.pm = pm0 + fm + ((wgid % nig) % gsz); u.pn = (wgid % nig) / gsz; u.ex = 0; return true;
    }
    DI size_t a_off(const Unit& u) const { return (size_t)u.pm * tA; }
    DI size_t b_off(const Unit& u) const { return (size_t)u.pn * tB; }
};
struct PanelOrder {
    int nM, G, c; size_t tA, tB;
    DI bool next(int i, Unit& u) const { const int pm = c + (i >> 2) * G; if (pm >= nM) return false; u.pm = pm; u.pn = i & 3; u.ex = 0; return true; }
    DI size_t a_off(const Unit& u) const { return (size_t)u.pm * tA; }
    DI size_t b_off(const Unit& u) const { return (size_t)u.pn * tB; }
};
struct CmpOrder {
    int G, c;
    DI bool next(int i, Unit& u) const { const int L = i * G + c; if (L >= 64) return false; u.pm = L; u.pn = 0; u.ex = 0; return true; }
    DI size_t a_off(const Unit& u) const { const int combo = u.pm >> 4, which = combo >> 1, g = combo & 1; return ((size_t)(u.pm & 15) * 256 * 16 * ZP + (which ? Z_VC : Z_KC) + g * 64) * 2; }
    DI size_t b_off(const Unit& u) const { return (size_t)(u.pm >> 5) * 256 * 2048 * 2; }
};
struct MoeOrder {
    const LAS int* info; int n; int pm0; size_t tA, tB, eB;
    DI bool next(int i, Unit& u) const { if (i >= n) return false; u.pm = info[4 * i]; u.pn = info[4 * i + 1]; u.ex = info[4 * i + 2]; return true; }
    DI size_t a_off(const Unit& u) const { return (size_t)(u.pm - pm0) * tA; }
    DI size_t b_off(const Unit& u) const { return (size_t)u.ex * eB + (size_t)u.pn * tB; }
};

#ifndef ST_MODE
#define ST_MODE 1
#endif
template <int MODE> DI void st16(void* p, const u32x4& w) {
    if constexpr (MODE == 2) asm volatile("global_store_dwordx4 %0, %1, off sc1\n\ts_nop 1" :: "v"(p), "v"(w) : "memory");
    else if constexpr (MODE == 1) asm volatile("global_store_dwordx4 %0, %1, off nt\n\ts_nop 1" :: "v"(p), "v"(w) : "memory");
    else *(u32x4*)p = w;
}
template <int MODE> DI void st8(void* p, const u32x2& w) {
    if constexpr (MODE == 2) asm volatile("global_store_dwordx2 %0, %1, off sc1\n\ts_nop 1" :: "v"(p), "v"(w) : "memory");
    else *(u32x2*)p = w;
}
template <int MODE> DI void st16o(void* base, unsigned off, const u32x4& w) {
    if constexpr (MODE == 2) asm volatile("global_store_dwordx4 %0, %1, %2 sc1\n\ts_nop 1" :: "v"(off), "v"(w), "s"(base) : "memory");
    else *(u32x4*)((char*)base + off) = w;
}
template <int MODE> DI void st8o(void* base, unsigned off, const u32x2& w) {
    if constexpr (MODE == 2) asm volatile("global_store_dwordx2 %0, %1, %2 sc1\n\ts_nop 1" :: "v"(off), "v"(w), "s"(base) : "memory");
    else *(u32x2*)((char*)base + off) = w;
}
constexpr int ST_OUT = (ST_MODE == 2) ? 2 : 0;
DI u32x4 pair16(const u32x2& wa, const u32x2& wb) {
    const u32x2 s0 = __builtin_amdgcn_permlane16_swap(wa.x, wb.x, false, false), s1 = __builtin_amdgcn_permlane16_swap(wa.y, wb.y, false, false);
    return (u32x4){s0.x, s1.x, s0.y, s1.y};
}
template <int ACT  , int SM = 0  > struct EpiBf16 {
    static constexpr bool PERM = true;
    bf16* O; int ldc; const float* bias; int bias_shift; float osc = 1.0f; int ncv = 1 << 30;
    DI void operator()(const f32x4 (&acc)[2][2][4][2], const Unit& u, int wr, int wc, int fr, int fq, const float (&rs)[2][4]) const {
        const int row0 = u.pm * BM + wr * 64 + fr, col0 = u.pn * BM + wc * 32 + 8 * fq;
        f32x4 bv[2][2];
#pragma unroll
        for (int bj = 0; bj < 2; ++bj)
#pragma unroll
            for (int n = 0; n < 2; ++n) bv[bj][n] = (ACT == 2) ? *(const f32x4*)(bias + (size_t)(u.pm >> bias_shift) * 256 + col0 + bj * HALF + 4 * n) : (f32x4){0.f, 0.f, 0.f, 0.f};
#pragma unroll
        for (int ai = 0; ai < 2; ++ai)
#pragma unroll
            for (int m = 0; m < 4; ++m) { bf16* rowp = O + (size_t)(row0 + ai * HALF + m * 16) * ldc + col0;
#pragma unroll
                for (int bj = 0; bj < 2; ++bj) { const float r_ = rs[ai][m] * osc; f32x4 v0 = acc[ai][bj][m][0] * r_ + bv[bj][0], v1 = acc[ai][bj][m][1] * r_ + bv[bj][1];
                    if (ACT == 2) {
#pragma unroll
                        for (int e = 0; e < 4; ++e) { float x = v0[e]; float uu = 0.7978845608f * (x + 0.044715f * x * x * x); v0[e] = x * frcp(1.f + fexp2(-2.f * LOG2E * uu));
                                                      x = v1[e]; uu = 0.7978845608f * (x + 0.044715f * x * x * x); v1[e] = x * frcp(1.f + fexp2(-2.f * LOG2E * uu)); } }
                    u32x4 w; w.x = pk(v0[0], v0[1]); w.y = pk(v0[2], v0[3]); w.z = pk(v1[0], v1[1]); w.w = pk(v1[2], v1[3]);
                    if (col0 + bj * HALF < ncv) st16<SM>(rowp + bj * HALF, w); } }
    }
};
struct EpiOut8 {
    static constexpr bool PERM = true;
    unsigned char* O; int ldc; float osc;
    DI void operator()(const f32x4 (&acc)[2][2][4][2], const Unit& u, int wr, int wc, int fr, int fq, const float (&rs)[2][4]) const {
        const int row0 = u.pm * BM + wr * 64 + fr, col0 = u.pn * BM + wc * 32 + 8 * (fq & ~1);
#pragma unroll
        for (int ai = 0; ai < 2; ++ai)
#pragma unroll
            for (int bj = 0; bj < 2; ++bj) { u32x2 w[4];
#pragma unroll
                for (int m = 0; m < 4; ++m) { const f32x4 v0 = acc[ai][bj][m][0] * osc, v1 = acc[ai][bj][m][1] * osc; w[m].x = pk8(v0[0], v0[1], v0[2], v0[3]); w[m].y = pk8(v1[0], v1[1], v1[2], v1[3]); }
#pragma unroll
                for (int mp = 0; mp < 2; ++mp) { const u32x4 o16 = pair16(w[2 * mp], w[2 * mp + 1]);
                    *(u32x4*)(O + (size_t)(row0 + ai * HALF + (2 * mp + (fq & 1)) * 16) * ldc + col0 + bj * HALF) = o16; } }
    }
};
template <bool W8> struct EpiRes16 {
    static constexpr bool PERM = true;
    const bf16* base; bf16* out; float* ss; unsigned char* h8; float sc;
    DI void operator()(const f32x4 (&acc)[2][2][4][2], const Unit& u, int wr, int wc, int fr, int fq, const float (&rs)[2][4]) const {
        const int row0 = u.pm * BM + wr * 64 + fr, col0 = u.pn * BM + wc * 32 + 8 * fq;
        const unsigned o0 = ((unsigned)row0 * D + col0) * 2u;
#pragma unroll
        for (int ai = 0; ai < 2; ++ai) {
            u32x4 bb[4][2];
#pragma unroll
            for (int m = 0; m < 4; ++m)
#pragma unroll
                for (int bj = 0; bj < 2; ++bj) bb[m][bj] = *(const u32x4*)((const char*)base + (o0 + (unsigned)(((ai * HALF + m * 16) * D + bj * HALF) * 2)));
            float sqv[4]; u32x2 w8[4][2];
#pragma unroll
            for (int m = 0; m < 4; ++m) { float sq = 0.f;
#pragma unroll
                for (int bj = 0; bj < 2; ++bj) { const u32x4 b = bb[m][bj]; const f32x4 a0 = acc[ai][bj][m][0] * sc, a1 = acc[ai][bj][m][1] * sc;
                    const float h0 = bflo(b.x) + a0[0], h1 = bfhi(b.x) + a0[1], h2 = bflo(b.y) + a0[2], h3 = bfhi(b.y) + a0[3], h4 = bflo(b.z) + a1[0], h5 = bfhi(b.z) + a1[1], h6 = bflo(b.w) + a1[2], h7 = bfhi(b.w) + a1[3];
                    sq += ((h0 * h0 + h1 * h1) + (h2 * h2 + h3 * h3)) + ((h4 * h4 + h5 * h5) + (h6 * h6 + h7 * h7));
                    const unsigned o2 = o0 + (unsigned)(((ai * HALF + m * 16) * D + bj * HALF) * 2);
                    u32x4 w; w.x = pk(h0, h1); w.y = pk(h2, h3); w.z = pk(h4, h5); w.w = pk(h6, h7); st16o<ST_OUT>(out, o2, w);
                    if constexpr (W8) { w8[m][bj].x = pk8(h0 * S8_H, h1 * S8_H, h2 * S8_H, h3 * S8_H); w8[m][bj].y = pk8(h4 * S8_H, h5 * S8_H, h6 * S8_H, h7 * S8_H); } }
                sq += __shfl_xor(sq, 16); sq += __shfl_xor(sq, 32); sqv[m] = sq; }
            { const float sqm = fq == 0 ? sqv[0] : fq == 1 ? sqv[1] : fq == 2 ? sqv[2] : sqv[3]; ss[(size_t)(row0 + ai * HALF + fq * 16) * 16 + 4 * u.pn + wc] = sqm; }
            if constexpr (W8) {
#pragma unroll
                for (int mp = 0; mp < 2; ++mp)
#pragma unroll
                    for (int bj = 0; bj < 2; ++bj) { const u32x4 o16 = pair16(w8[2 * mp][bj], w8[2 * mp + 1][bj]);
                        *(u32x4*)(h8 + (size_t)(row0 + ai * HALF + (2 * mp + (fq & 1)) * 16) * D + u.pn * BM + wc * 32 + 8 * (fq & ~1) + bj * HALF) = o16; } }
        }
    }
};
struct EpiSwiGLU16 {
    static constexpr bool PERM = true;
    bf16* O; int rowsub; float sc = 1.0f;
    DI void operator()(const f32x4 (&acc)[2][2][4][2], const Unit& u, int wr, int wc, int fr, int fq, const float (&rs)[2][4]) const {
        const int row0 = u.pm * BM - rowsub + wr * 64 + fr, col0 = u.pn * HALF + wc * 32 + 8 * fq;
#pragma unroll
        for (int ai = 0; ai < 2; ++ai)
#pragma unroll
            for (int m = 0; m < 4; ++m) { f32x4 h0, h1;
#pragma unroll
                for (int e = 0; e < 4; ++e) { const float r_ = rs[ai][m] * sc; h0[e] = siluf_(acc[ai][0][m][0][e] * r_) * (acc[ai][1][m][0][e] * r_); h1[e] = siluf_(acc[ai][0][m][1][e] * r_) * (acc[ai][1][m][1][e] * r_); }
                u32x4 w; w.x = pk(h0[0], h0[1]); w.y = pk(h0[2], h0[3]); w.z = pk(h1[0], h1[1]); w.w = pk(h1[2], h1[3]);
                st16<ST_OUT>(O + (size_t)(row0 + ai * HALF + m * 16) * DFF + col0, w); }
    }
};
struct EpiSwiGLU {
    static constexpr bool PERM = true;
    unsigned char* O; int rowsub; float sc;
    DI void operator()(const f32x4 (&acc)[2][2][4][2], const Unit& u, int wr, int wc, int fr, int fq, const float (&rs)[2][4]) const {
        const int row0 = u.pm * BM - rowsub + wr * 64 + fr, col0 = u.pn * HALF + wc * 32 + 8 * (fq & ~1);
#pragma unroll
        for (int ai = 0; ai < 2; ++ai) { u32x2 w[4];
#pragma unroll
            for (int m = 0; m < 4; ++m) { f32x4 h0, h1; const float r_ = rs[ai][m] * sc, ru = r_ * S8_HID;
#pragma unroll
                for (int n = 0; n < 2; ++n)
#pragma unroll
                    for (int e = 0; e < 4; e += 2) {
                        const f32x2 g = (f32x2){acc[ai][0][m][n][e], acc[ai][0][m][n][e + 1]} * r_, u = (f32x2){acc[ai][1][m][n][e], acc[ai][1][m][n][e + 1]} * ru;
                        const f32x2 t = g * (-LOG2E); const f32x2 d = (f32x2){fexp2(t[0]), fexp2(t[1])} + 1.0f; const f32x2 h = g * (f32x2){frcp(d[0]), frcp(d[1])} * u;
                        if (n == 0) { h0[e] = h[0]; h0[e + 1] = h[1]; } else { h1[e] = h[0]; h1[e + 1] = h[1]; } }
                w[m].x = pk8(h0[0], h0[1], h0[2], h0[3]); w[m].y = pk8(h1[0], h1[1], h1[2], h1[3]); }
#pragma unroll
            for (int mp = 0; mp < 2; ++mp) { const u32x4 o16 = pair16(w[2 * mp], w[2 * mp + 1]);
                *(u32x4*)(O + (size_t)(row0 + ai * HALF + (2 * mp + (fq & 1)) * 16) * DFF + col0) = o16; } }
    }
};
struct EpiSig8 {
    static constexpr bool PERM = true;
    unsigned char* O; float osc = 1.0f;
    DI void operator()(const f32x4 (&acc)[2][2][4][2], const Unit& u, int wr, int wc, int fr, int fq, const float (&rs)[2][4]) const {
        const int row0 = u.pm * BM + wr * 64 + fr, col0 = u.pn * BM + wc * 32 + 8 * (fq & ~1);
#pragma unroll
        for (int ai = 0; ai < 2; ++ai)
#pragma unroll
            for (int bj = 0; bj < 2; ++bj) { u32x2 w[4];
#pragma unroll
                for (int m = 0; m < 4; ++m) { const float rt = rs[ai][m] * osc * (-LOG2E); unsigned p[2] = {0u, 0u};
#pragma unroll
                    for (int n = 0; n < 2; ++n)
#pragma unroll
                        for (int e = 0; e < 4; e += 2) { const f32x2 t = (f32x2){acc[ai][bj][m][n][e], acc[ai][bj][m][n][e + 1]} * rt; const f32x2 d = (f32x2){fexp2(t[0]), fexp2(t[1])} + 1.0f;
                            const f32x2 sg = (f32x2){frcp(d[0]), frcp(d[1])} * 255.0f + 0.5f;
                            p[n] = __builtin_amdgcn_cvt_pk_u8_f32(sg[0], e, p[n]); p[n] = __builtin_amdgcn_cvt_pk_u8_f32(sg[1], e + 1, p[n]); }
                    w[m].x = p[0]; w[m].y = p[1]; }
#pragma unroll
                for (int mp = 0; mp < 2; ++mp) *(u32x4*)(O + (size_t)(row0 + ai * HALF + (2 * mp + (fq & 1)) * 16) * D + col0 + bj * HALF) = pair16(w[2 * mp], w[2 * mp + 1]); }
    }
};
template <bool NORM> struct EpiPleApply {
    static constexpr bool PERM = true;
    const bf16* base; const unsigned char* SG; bf16* out; float* ss; unsigned char* h8 = nullptr;
    DI void operator()(const f32x4 (&acc)[2][2][4][2], const Unit& u, int wr, int wc, int fr, int fq, const float (&rs)[2][4]) const {
        const int row0 = u.pm * BM + wr * 64 + fr, col0 = u.pn * BM + wc * 32 + 8 * fq;
        const unsigned o0 = ((unsigned)row0 * D + col0) * 2u;
#pragma unroll
        for (int ai = 0; ai < 2; ++ai) {
            u32x4 bb[4][2]; u32x2 sg[4][2];
#pragma unroll
            for (int m = 0; m < 4; ++m)
#pragma unroll
                for (int bj = 0; bj < 2; ++bj) bb[m][bj] = *(const u32x4*)((const char*)base + (o0 + (unsigned)(((ai * HALF + m * 16) * D + bj * HALF) * 2)));
#pragma unroll
            for (int mp = 0; mp < 2; ++mp)
#pragma unroll
                for (int bj = 0; bj < 2; ++bj) { const u32x4 L = *(const u32x4*)(SG + (size_t)(row0 + ai * HALF + (2 * mp + (fq & 1)) * 16) * D + u.pn * BM + wc * 32 + 8 * (fq & ~1) + bj * HALF);
                    const u32x2 s0 = __builtin_amdgcn_permlane16_swap(L.x, L.z, false, false), s1 = __builtin_amdgcn_permlane16_swap(L.y, L.w, false, false);
                    sg[2 * mp][bj] = (u32x2){s0.x, s1.x}; sg[2 * mp + 1][bj] = (u32x2){s0.y, s1.y}; }
            float sqv[4];
#pragma unroll
            for (int m = 0; m < 4; ++m) { f32x2 sq2 = {0.f, 0.f};
#pragma unroll
                for (int bj = 0; bj < 2; ++bj) { const u32x4 b = bb[m][bj]; const u32x2 g8 = sg[m][bj]; const f32x4 a0 = acc[ai][bj][m][0], a1 = acc[ai][bj][m][1];
                    f32x2 hh[4];
#pragma unroll
                    for (int j = 0; j < 4; ++j) { const unsigned bw = j == 0 ? b.x : j == 1 ? b.y : j == 2 ? b.z : b.w; const unsigned gw = (j < 2) ? g8.x : g8.y; const int sh = 16 * (j & 1);
                        const f32x2 a2 = (j < 2) ? (f32x2){a0[2 * j], a0[2 * j + 1]} : (f32x2){a1[2 * j - 4], a1[2 * j - 3]};
                        const f32x2 sv = (f32x2){(float)((gw >> sh) & 0xffu), (float)((gw >> (sh + 8)) & 0xffu)} * (1.0f / 255.0f);
                        hh[j] = (f32x2){bflo(bw), bfhi(bw)} + a2 * sv;
                        if (NORM) sq2 = sq2 + hh[j] * hh[j]; }
                    const unsigned o2 = o0 + (unsigned)(((ai * HALF + m * 16) * D + bj * HALF) * 2);
                    u32x4 w; w.x = pk(hh[0][0], hh[0][1]); w.y = pk(hh[1][0], hh[1][1]); w.z = pk(hh[2][0], hh[2][1]); w.w = pk(hh[3][0], hh[3][1]); st16o<ST_OUT>(out, o2, w);
                    if constexpr (NORM && F8_IN1) { u32x2 w8; w8.x = pk8(hh[0][0] * S8_H, hh[0][1] * S8_H, hh[1][0] * S8_H, hh[1][1] * S8_H); w8.y = pk8(hh[2][0] * S8_H, hh[2][1] * S8_H, hh[3][0] * S8_H, hh[3][1] * S8_H); *(u32x2*)(h8 + (o2 >> 1)) = w8; } }
                if (NORM) { float sq = sq2[0] + sq2[1]; sq += __shfl_xor(sq, 16); sq += __shfl_xor(sq, 32); sqv[m] = sq; } }
            if (NORM) { const float sqm = fq == 0 ? sqv[0] : fq == 1 ? sqv[1] : fq == 2 ? sqv[2] : sqv[3]; ss[(size_t)(row0 + ai * HALF + fq * 16) * 16 + 4 * u.pn + wc] = sqm; }
        }
    }
};
template <bool NORM> struct EpiPleGate {
    static constexpr bool PERM = true;
    const bf16* base; const bf16* PP; bf16* out; float* ss; unsigned char* h8 = nullptr;
    DI void operator()(const f32x4 (&acc)[2][2][4][2], const Unit& u, int wr, int wc, int fr, int fq, const float (&rs)[2][4]) const {
        const int row0 = u.pm * BM + wr * 64 + fr, col0 = u.pn * BM + wc * 32 + 8 * fq;
        const unsigned o0 = ((unsigned)row0 * D + col0) * 2u;
#pragma unroll
        for (int ai = 0; ai < 2; ++ai) {
            u32x4 bb[4][2], pq[4][2];
#pragma unroll
            for (int m = 0; m < 4; ++m)
#pragma unroll
                for (int bj = 0; bj < 2; ++bj) { const unsigned o2 = o0 + (unsigned)(((ai * HALF + m * 16) * D + bj * HALF) * 2); bb[m][bj] = *(const u32x4*)((const char*)base + o2); pq[m][bj] = *(const u32x4*)((const char*)PP + o2); }
            float sqv[4];
#pragma unroll
            for (int m = 0; m < 4; ++m) { float sq = 0.f; const float r_ = rs[ai][m];
#pragma unroll
                for (int bj = 0; bj < 2; ++bj) { const unsigned o2 = o0 + (unsigned)(((ai * HALF + m * 16) * D + bj * HALF) * 2); const u32x4 b = bb[m][bj], pp = pq[m][bj]; const f32x4 a0 = acc[ai][bj][m][0], a1 = acc[ai][bj][m][1];
                    const float h0 = bflo(b.x) + bflo(pp.x) * sigmoidf_(a0[0] * r_), h1 = bfhi(b.x) + bfhi(pp.x) * sigmoidf_(a0[1] * r_), h2 = bflo(b.y) + bflo(pp.y) * sigmoidf_(a0[2] * r_), h3 = bfhi(b.y) + bfhi(pp.y) * sigmoidf_(a0[3] * r_);
                    const float h4 = bflo(b.z) + bflo(pp.z) * sigmoidf_(a1[0] * r_), h5 = bfhi(b.z) + bfhi(pp.z) * sigmoidf_(a1[1] * r_), h6 = bflo(b.w) + bflo(pp.w) * sigmoidf_(a1[2] * r_), h7 = bfhi(b.w) + bfhi(pp.w) * sigmoidf_(a1[3] * r_);
                    if (NORM) sq += ((h0 * h0 + h1 * h1) + (h2 * h2 + h3 * h3)) + ((h4 * h4 + h5 * h5) + (h6 * h6 + h7 * h7));
                    u32x4 w; w.x = pk(h0, h1); w.y = pk(h2, h3); w.z = pk(h4, h5); w.w = pk(h6, h7); st16o<ST_OUT>(out, o2, w);
                    if constexpr (NORM && F8_IN1) { u32x2 w8; w8.x = pk8(h0 * S8_H, h1 * S8_H, h2 * S8_H, h3 * S8_H); w8.y = pk8(h4 * S8_H, h5 * S8_H, h6 * S8_H, h7 * S8_H); *(u32x2*)(h8 + (o2 >> 1)) = w8; } }
                if (NORM) { sq += __shfl_xor(sq, 16); sq += __shfl_xor(sq, 32); sqv[m] = sq; } }
            if (NORM) { const float sqm = fq == 0 ? sqv[0] : fq == 1 ? sqv[1] : fq == 2 ? sqv[2] : sqv[3]; ss[(size_t)(row0 + ai * HALF + fq * 16) * 16 + 4 * u.pn + wc] = sqm; }
        }
    }
};

#ifndef PROBE_REP
#define PROBE_REP 1
#endif
template <class E> constexpr int epi_rep = 1;
template <> constexpr int epi_rep<EpiBf16<0, ST_MODE>> = PROBE_REP;
template <class Epi, class Sched, bool GATHER, int RS = 0, bool F8 = false>
DI void gemm_phase(int tid_in, LAS unsigned char* lds, const Gemm g, const Sched& S, const Epi& E, const LAS int* gtab, const LAS float* rtab = nullptr) {
    int tid_ = tid_in; asm volatile("" : "+v"(tid_));
    const int tid = tid_, wid = __builtin_amdgcn_readfirstlane(tid >> 6), lane = tid & 63, wr = wid >> 2, wc = wid & 3, fr = lane & 15, fq = lane >> 4;
    const int K = g.K, nt = K / BK;
    unsigned vB[2], vA[2][2]; int rA[2]; unsigned cC[2];
#pragma unroll
    for (int i = 0; i < 2; ++i) { int R, C; stage_rc(tid * 16 + i * 8192, R, C); const int Rb = Epi::PERM ? ((R & ~31) + perm32(R & 31)) : R;
        rA[i] = R; cC[i] = (unsigned)C * 2u; vB[i] = (unsigned)(Rb * K + C) * 2u;
        vA[0][i] = (unsigned)(R * g.lda + C) * 2u; vA[1][i] = vA[0][i]; }
    const size_t kstepA = (size_t)g.kstepA, kstepB = (size_t)(BK * 2), hstepB = (size_t)HALF * K * 2, hstepA = GATHER ? (size_t)0 : (size_t)HALF * g.lda * 2;
    const unsigned ldsw = (unsigned)wid * 1024u;
    const int aoff = lds_byte(wr * 64 + fr, fq * 8), boff = lds_byte(wc * 32 + fr, fq * 8);
#define PG8_SA(b, h) (((b) * 2 + (h)) * HTB)
#define PG8_SB(b, h) ((4 + (b) * 2 + (h)) * HTB)
#define PG8_STAGE(bufoff, gbase, voff) do { _Pragma("unroll") for (int _i = 0; _i < 2; ++_i) \
        __builtin_amdgcn_global_load_lds((const unsigned*)((const char*)(gbase) + (voff)[_i]), (LAS unsigned*)(lds + (bufoff) + ldsw + _i * 8192), 16, 0, 0); } while (0)
#define PG8_LDA(dst, b, h) do { _Pragma("unroll") for (int m = 0; m < 4; ++m) _Pragma("unroll") for (int k = 0; k < 2; ++k) dst[m][k] = *(const LAS bf16x8*)(lds + PG8_SA(b, h) + aoff + m * 2048 + k * 1024); } while (0)
#define PG8_LDB(dst, b, h) do { _Pragma("unroll") for (int n = 0; n < 2; ++n) _Pragma("unroll") for (int k = 0; k < 2; ++k) dst[n][k] = *(const LAS bf16x8*)(lds + PG8_SB(b, h) + boff + n * 2048 + k * 1024); } while (0)
#define PG8_CAT(x0, x1) __builtin_shufflevector(__builtin_bit_cast(i32x4_t, (x0)), __builtin_bit_cast(i32x4_t, (x1)), 0, 1, 2, 3, 4, 5, 6, 7)
#define PG8_MMA(ai, bj, At, Bt) do { __builtin_amdgcn_s_setprio(1); _Pragma("unroll") for (int m = 0; m < 4; ++m) _Pragma("unroll") for (int n = 0; n < 2; ++n) { \
        if constexpr (F8) asm volatile("v_mfma_f32_16x16x128_f8f6f4 %0, %1, %2, %0" : "+v"(acc[ai][bj][m][n]) : "v"(PG8_CAT(Bt[n][0], Bt[n][1])), "v"(PG8_CAT(At[m][0], At[m][1]))); \
        else { _Pragma("unroll") for (int k = 0; k < 2; ++k) acc[ai][bj][m][n] = __builtin_amdgcn_mfma_f32_16x16x32_bf16(Bt[n][k], At[m][k], acc[ai][bj][m][n], 0, 0, 0); } } \
        __builtin_amdgcn_s_setprio(0); } while (0)
#define PG8_WAIT_V(n) asm volatile("s_waitcnt vmcnt(" #n ")" ::: "memory")
#define PG8_WAIT_L(n) asm volatile("s_waitcnt lgkmcnt(" #n ")" ::: "memory")
#define PG8_BAR __builtin_amdgcn_s_barrier()
#define PG8_SCHED __builtin_amdgcn_sched_barrier(0)
#define PG8_GROWS(dst, slot) do { if constexpr (GATHER) { _Pragma("unroll") for (int _h = 0; _h < 2; ++_h) _Pragma("unroll") for (int _i = 0; _i < 2; ++_i) \
        dst[_h][_i] = (unsigned)gtab[(slot) * 256 + _h * HALF + rA[_i]] * (unsigned)(g.lda * 2) + cC[_i]; } } while (0)
    Unit cur, nxt; int ui = 0;
    if (!S.next(0, cur)) return;
    f32x4 acc[2][2][4][2];
#pragma unroll
    for (int a = 0; a < 2; ++a)
#pragma unroll
        for (int b = 0; b < 2; ++b)
#pragma unroll
            for (int m = 0; m < 4; ++m)
#pragma unroll
                for (int n = 0; n < 2; ++n) acc[a][b][m][n] = (f32x4){0.f, 0.f, 0.f, 0.f};
    bf16x8 At[4][2], B0[2][2], B1[2][2];
    const char* cA = (const char*)g.A + S.a_off(cur); const char* cB = (const char*)g.Bt + S.b_off(cur);
    PG8_GROWS(vA, 0);
    int rslot = 0;
#define PG8_LOADRS() do { _Pragma("unroll") for (int _a = 0; _a < 2; ++_a) _Pragma("unroll") for (int _m = 0; _m < 4; ++_m) \
        rs[_a][_m] = (RS == 1) ? rtab[rslot * 256 + _a * HALF + wr * 64 + _m * 16 + fr] : 1.0f; } while (0)
    PG8_STAGE(PG8_SB(0, 0), cB, vB); PG8_STAGE(PG8_SB(0, 1), cB + hstepB, vB); PG8_STAGE(PG8_SA(0, 0), cA, vA[0]); PG8_STAGE(PG8_SA(0, 1), cA + hstepA, vA[1]);
    if (wr == 1) PG8_BAR;
    PG8_WAIT_V(2); PG8_BAR;
    PG8_STAGE(PG8_SB(1, 0), cB + kstepB, vB); PG8_STAGE(PG8_SA(1, 0), cA + kstepA, vA[0]); PG8_STAGE(PG8_SB(1, 1), cB + hstepB + kstepB, vB);
    PG8_WAIT_V(6); PG8_BAR;
    for (;;) {
        const bool has_next = S.next(ui + 1, nxt);
        const char* nA = has_next ? (const char*)g.A + S.a_off(nxt) : cA; const char* nB = has_next ? (const char*)g.Bt + S.b_off(nxt) : cB;

#pragma nounroll
        for (int t = 0; t < nt; t += 2) {
            const bool last = (t == nt - 2);
            const char* a1 = cA + (size_t)(t + 1) * kstepA;
            const char* a2 = last ? nA : cA + (size_t)(t + 2) * kstepA; const char* b2 = last ? nB : cB + (size_t)(t + 2) * kstepB;
            const char* a3 = a2 + kstepA; const char* b3 = b2 + kstepB;
            PG8_LDB(B0, 0, 0); PG8_LDB(B1, 0, 1); PG8_SCHED; PG8_LDA(At, 0, 0); PG8_STAGE(PG8_SA(1, 1), a1 + hstepA, vA[1]);
            PG8_WAIT_V(8); PG8_WAIT_L(0); PG8_BAR; PG8_MMA(0, 0, At, B0); PG8_MMA(0, 1, At, B1); PG8_BAR; PG8_SCHED;
            if constexpr (GATHER) { if (last && has_next) { PG8_GROWS(vA, rslot + (nxt.pm != cur.pm ? 1 : 0)); } }
            PG8_LDA(At, 0, 1); PG8_STAGE(PG8_SB(0, 0), b2, vB); PG8_STAGE(PG8_SB(0, 1), b2 + hstepB, vB); PG8_STAGE(PG8_SA(0, 0), a2, vA[0]);
            PG8_WAIT_V(8); PG8_WAIT_L(0); PG8_BAR; PG8_MMA(1, 0, At, B0); PG8_MMA(1, 1, At, B1); PG8_BAR; PG8_SCHED;
            PG8_LDB(B0, 1, 0); PG8_LDB(B1, 1, 1); PG8_SCHED; PG8_LDA(At, 1, 0); PG8_STAGE(PG8_SA(0, 1), a2 + hstepA, vA[1]);
            PG8_WAIT_V(8); PG8_WAIT_L(0); PG8_BAR; PG8_MMA(0, 0, At, B0); PG8_MMA(0, 1, At, B1); PG8_BAR; PG8_SCHED;
            PG8_LDA(At, 1, 1); PG8_STAGE(PG8_SB(1, 0), b3, vB); PG8_STAGE(PG8_SB(1, 1), b3 + hstepB, vB); PG8_STAGE(PG8_SA(1, 0), a3, vA[0]);
            PG8_WAIT_V(8); PG8_WAIT_L(0); PG8_BAR; PG8_MMA(1, 0, At, B0); PG8_MMA(1, 1, At, B1); PG8_BAR; PG8_SCHED;
        }
        if constexpr (F8) asm volatile("s_nop 15\n\ts_nop 15" ::: "memory");
        if (wr == 0) PG8_BAR;
        float rs[2][4];
        PG8_LOADRS();
#pragma unroll
        for (int er = 0; er < epi_rep<Epi>; ++er) E(acc, cur, wr, wc, fr, fq, rs);
        if (!has_next) break;
#pragma unroll
        for (int a = 0; a < 2; ++a)
#pragma unroll
            for (int b = 0; b < 2; ++b)
#pragma unroll
                for (int m = 0; m < 4; ++m)
#pragma unroll
                    for (int n = 0; n < 2; ++n) acc[a][b][m][n] = (f32x4){0.f, 0.f, 0.f, 0.f};
        if (nxt.pm != cur.pm) ++rslot;
        cur = nxt; cA = nA; cB = nB; ++ui;
        if (wr == 1) PG8_BAR;
    }
    PG8_WAIT_V(0);
    PG8_BAR;
#undef PG8_SA
#undef PG8_SB
#undef PG8_STAGE
#undef PG8_LDA
#undef PG8_LDB
#undef PG8_MMA
#undef PG8_CAT
#undef PG8_WAIT_V
#undef PG8_WAIT_L
#undef PG8_BAR
#undef PG8_SCHED
#undef PG8_GROWS
#undef PG8_LOADRS
}
}

#define XB_TMO      128
#define XB_XCNT(j)  (256  + 64 * (j))
#define XB_XSUB(j)  (1280 + 64 * (j))
#define XB_XGEN(j)  (2304 + 64 * (j))
#define XB_TOP      3328
#define XB_TOPGEN   3392
#define XCD_BAR_WORDS 3456
#define XB_SPIN_CAP (1u << 22)
DI unsigned xb_ld(unsigned* p)              { return __hip_atomic_load(p, __ATOMIC_RELAXED, __HIP_MEMORY_SCOPE_AGENT); }
DI unsigned xb_add(unsigned* p, unsigned v) { return __hip_atomic_fetch_add(p, v, __ATOMIC_RELAXED, __HIP_MEMORY_SCOPE_AGENT); }
DI int lane_now() { unsigned z = 0u; asm volatile("" : "+v"(z)); return (int)__builtin_amdgcn_mbcnt_hi(~0u, __builtin_amdgcn_mbcnt_lo(~0u, z)); }
DI unsigned xb_xcc_id() { return (unsigned)__builtin_amdgcn_s_getreg((3 << 11) | 20) & 0xFu; }
#define XB_SPIN(cond, bar) do { unsigned _sp = 0; while (cond) { __builtin_amdgcn_s_sleep(1); \
    if ((++_sp & 255u) == 0u) { if (xb_ld(&(bar)[XB_TMO])) break; if (_sp > XB_SPIN_CAP) { atomicAdd(&(bar)[XB_TMO], 1u); break; } } } } while (0)
struct XcdBarrier { unsigned* bar; unsigned x; volatile LAS unsigned* st; };
DI XcdBarrier xcd_barrier_post(unsigned* bar, volatile LAS unsigned* st, int wave0) {
    XcdBarrier b; b.bar = bar; b.x = xb_xcc_id(); b.st = st;
    if ((wave0 * 64 + lane_now()) == 0) (void)xb_add(&bar[XB_XCNT(b.x)], 1u);
    return b;
}
DI void xcd_barrier_complete(unsigned* bar, unsigned x, unsigned& nloc, unsigned& nx) {
    const unsigned G = gridDim.x * gridDim.y * gridDim.z;
    unsigned sum, cnt, mine, sp = 0u;
    for (;;) {
        sum = 0u; cnt = 0u; mine = 0u;
#pragma unroll
        for (unsigned j = 0; j < 16; ++j) { const unsigned c = xb_ld(&bar[XB_XCNT(j)]); sum += c; cnt += (c > 0u) ? 1u : 0u; mine = (j == x) ? c : mine; }
        if (sum == G) break;
        __builtin_amdgcn_s_sleep(1);
        if ((++sp & 255u) == 0u) { if (xb_ld(&bar[XB_TMO])) break; if (sp > XB_SPIN_CAP) { atomicAdd(&bar[XB_TMO], 1u); break; } }
    }
    nloc = mine > 0u ? mine : 1u; nx = cnt > 0u ? cnt : 1u;
}
DI void xcd_barrier(const XcdBarrier& b, int wave0) {
    asm volatile("s_waitcnt vmcnt(0)" ::: "memory");
    __syncthreads();
    if ((wave0 * 64 + lane_now()) == 0) {
        unsigned bx = b.x; GAS unsigned* barg = (GAS unsigned*)b.bar; asm volatile("" : "+s"(bx), "+s"(barg)); unsigned* bar = (unsigned*)barg;
        __builtin_amdgcn_s_waitcnt(0);
        unsigned nloc = b.st[0], nx = b.st[1];
        if (nloc == 0u) { xcd_barrier_complete(bar, bx, nloc, nx); b.st[0] = nloc; b.st[1] = nx; }
        const unsigned old = xb_add(&bar[XB_XSUB(bx)], 1u);
        const unsigned gen = old / nloc;
        if (old + 1u == (gen + 1u) * nloc) {
            __builtin_amdgcn_fence(__ATOMIC_RELEASE, "agent");
            asm volatile("s_waitcnt vmcnt(0)" ::: "memory");
            const unsigned og = xb_add(&bar[XB_TOP], 1u);
            const unsigned tg = og / nx;
            if (og + 1u == (tg + 1u) * nx) xb_add(&bar[XB_TOPGEN], 1u);
            else XB_SPIN(xb_ld(&bar[XB_TOPGEN]) == tg, bar);
            __builtin_amdgcn_fence(__ATOMIC_ACQUIRE, "agent");
            xb_add(&bar[XB_XGEN(bx)], 1u);
            asm volatile("s_waitcnt vmcnt(0)" ::: "memory");
        } else {
            XB_SPIN(xb_ld(&bar[XB_XGEN(bx)]) == gen, bar);
            __builtin_amdgcn_fence(__ATOMIC_ACQUIRE, "agent");
            asm volatile("s_waitcnt vmcnt(0)" ::: "memory");
        }
    }
    __syncthreads();
}

struct Args { const float* in[21]; float* out; unsigned char* ws; };
enum { I_X = 0, I_P, I_WIN, I_WOUT, I_GMIX, I_GFFN, I_GPLE, I_GFINAL, I_CPOS, I_CW1, I_CW2, I_RETGN, I_FGATE, I_FUP, I_FDOWN, I_ROUTER, I_MGATE, I_MUP, I_MDOWN, I_PPROJ, I_PGATE };
struct Frame { LAS unsigned char* lds; unsigned char* ws; int tid, lane, wave, G, bid, wave0; };

DI void relaunder(Frame& F) { int w = __builtin_amdgcn_readfirstlane(F.wave0), l = lane_now(); asm volatile("" : "+s"(w), "+v"(l)); F.wave0 = w; F.tid = w * 64 + l; F.lane = l; F.wave = w;
    int g = (int)gridDim.x, b = (int)blockIdx.x; asm volatile("" : "+s"(g), "+s"(b)); F.G = g; F.bid = b; }

struct Seg { const float* src; bf16* dst; int K, Nsrc, nsrc0, ncols, nvalid, ndst0, ilv; const float* gain; int f8; float wsc; };
constexpr int NSEG = 2 * 8 + 3 + NE * 3;
DI Seg seg_decode(const Args& a, int s) {
    Seg g; unsigned char* ws = a.ws;
    if (s < 16) { const int L = s >> 3, k = s & 7; unsigned char* wl = ws + WS_W + L * WL_STRIDE;
        if (k == 0) g = Seg{a.in[I_WIN] + (size_t)L * D * IN_COLS, (bf16*)(wl + WL_WIN), D, IN_COLS, 0, 1280, 1280, 0, 0, a.in[I_GMIX] + L * D, (F8_IN1 && L == 1) ? 1 : 0, S8_WU};
        else if (k == 1) g = Seg{a.in[I_WIN] + (size_t)L * D * IN_COLS, (bf16*)(wl + WL_WIN), D, IN_COLS, 1304, 2048, 2048, 1280, 0, a.in[I_GMIX] + L * D, (F8_IN1 && L == 1) ? 1 : 0, S8_WU};
        else if (k == 2) g = Seg{a.in[I_WIN] + (size_t)L * D * IN_COLS, (bf16*)(wl + WL_WIN), D, IN_COLS, 1280, 256, 24, 3328, 0, a.in[I_GMIX] + L * D, (F8_IN1 && L == 1) ? 1 : 0, S8_WU};
        else if (k == 3) g = Seg{a.in[I_WOUT] + (size_t)L * D * D, (bf16*)(wl + WL_WOUT), D, D, 0, D, D, 0, 0, nullptr};
        else if (k == 4) g = Seg{a.in[I_PGATE] + (size_t)L * D * D, (bf16*)(wl + WL_PGATE), D, D, 0, D, D, 0, 0, a.in[I_GPLE] + L * D, F8_GATE, S8_WU};
        else if (k == 5) g = Seg{a.in[I_PPROJ] + (size_t)L * PLE * D, (bf16*)(wl + WL_PPROJ), PLE, D, 0, D, D, 0, 0, nullptr};
        else { const int which = k - 6; g = Seg{a.in[I_CW1] + (size_t)(L * 2 + which) * 2048 * 256, (bf16*)(wl + WL_CW1) + (size_t)which * 256 * 2048, 2048, 256, 0, 256, 256, 0, 0, nullptr}; }
    } else if (s < 19) { const int k = s - 16;
        if (k == 0) g = Seg{a.in[I_FGATE], (bf16*)(ws + WS_WDENSE), D, DFF, 0, DFF, DFF, 0, 1, a.in[I_GFFN], F8_DUP, S8_WU};
        else if (k == 1) g = Seg{a.in[I_FUP], (bf16*)(ws + WS_WDENSE), D, DFF, 0, DFF, DFF, 0, 2, a.in[I_GFFN], F8_DUP, S8_WU};
        else g = Seg{a.in[I_FDOWN], (bf16*)(ws + WS_WDENSE + 14 * MiB), DFF, D, 0, D, D, 0, 0, nullptr, F8_DDN, S8_WD};
    } else { const int e = (s - 19) / 3, k = (s - 19) % 3; unsigned char* we = ws + WS_WMOE + (size_t)e * WE_STRIDE;
        if (k == 0) g = Seg{a.in[I_MGATE] + (size_t)e * D * DFF, (bf16*)we, D, DFF, 0, DFF, DFF, 0, 1, a.in[I_GFFN] + D, F8_MOE, S8_WU};
        else if (k == 1) g = Seg{a.in[I_MUP] + (size_t)e * D * DFF, (bf16*)we, D, DFF, 0, DFF, DFF, 0, 2, a.in[I_GFFN] + D, F8_MOE, S8_WU};
        else g = Seg{a.in[I_MDOWN] + (size_t)e * DFF * D, (bf16*)(we + WE_DOWN), DFF, D, 0, D, D, 0, 0, nullptr, F8_MOE, S8_WD};
    }
    return g;
}
DI void transpose_load(const Seg& g, int item, int lane, f32x4 (&r)[8]) {
    const int nblk = g.ncols / 32, kb = item / nblk, nb = item % nblk, k0 = 64 * kb, n0 = 32 * nb;
    const int c4 = (lane & 7) * 4; const int nv = g.nvalid - n0;
#pragma unroll
    for (int i = 0; i < 8; ++i) { const int kk = i * 8 + (lane >> 3); r[i] = (c4 < nv) ? *(const f32x4*)(g.src + (size_t)(k0 + kk) * g.Nsrc + g.nsrc0 + n0 + c4) : (f32x4){0.f, 0.f, 0.f, 0.f};
        if (g.gain) r[i] = r[i] * g.gain[k0 + kk]; }
}
DI void transpose_store(const Seg& g, LAS float* scr, int item, int lane, const f32x4 (&r)[8]) {
    const int nblk = g.ncols / 32, kb = item / nblk, nb = item % nblk, k0 = 64 * kb, n0 = 32 * nb;
    const int c4 = (lane & 7) * 4;
#pragma unroll
    for (int i = 0; i < 8; ++i) { const int kk = i * 8 + (lane >> 3); LAS float* d = scr + kk * 33 + c4; d[0] = r[i][0]; d[1] = r[i][1]; d[2] = r[i][2]; d[3] = r[i][3]; }
    asm volatile("s_waitcnt lgkmcnt(0)" ::: "memory");
    const int c8 = lane & 7;
#pragma unroll
    for (int j = 0; j < 4; ++j) { const int n = (lane >> 3) + 8 * j; const LAS float* s = scr + (8 * c8) * 33 + n;
        const int na = n0 + n; const int drow = g.ilv ? ((na >> 7) * 256 + (na & 127) + (g.ilv == 2 ? 128 : 0)) : (g.ndst0 + na);
        if (g.f8) { const float c = g.wsc; u32x2 o; o.x = pk8(s[0 * 33] * c, s[1 * 33] * c, s[2 * 33] * c, s[3 * 33] * c); o.y = pk8(s[4 * 33] * c, s[5 * 33] * c, s[6 * 33] * c, s[7 * 33] * c);
            *(u32x2*)((unsigned char*)g.dst + (size_t)drow * g.K + k0 + 8 * c8) = o; }
        else { u32x4 o; o.x = pk(s[0 * 33], s[1 * 33]); o.y = pk(s[2 * 33], s[3 * 33]); o.z = pk(s[4 * 33], s[5 * 33]); o.w = pk(s[6 * 33], s[7 * 33]);
            *(u32x4*)(g.dst + (size_t)drow * g.K + k0 + 8 * c8) = o; } }
    asm volatile("s_waitcnt lgkmcnt(0)" ::: "memory");
}

DI void row_load(const float* row, int lane, f32x4 (&v)[4]) {
#pragma unroll
    for (int j = 0; j < 4; ++j) v[j] = *(const f32x4*)(row + 4 * lane + 256 * j);
}
DI float row_rstd(const f32x4 (&v)[4]) {
    float s = 0.f;
#pragma unroll
    for (int j = 0; j < 4; ++j) s += (v[j][0] * v[j][0] + v[j][1] * v[j][1]) + (v[j][2] * v[j][2] + v[j][3] * v[j][3]);
    return 1.0f / sqrtf(wave_sum(s) * (1.f / D) + EPS);
}
DI void row_store_bf16(bf16* orow, int lane, const f32x4 (&y)[4]) {
#pragma unroll
    for (int j = 0; j < 4; ++j) { u32x2 w; w.x = pk(y[j][0], y[j][1]); w.y = pk(y[j][2], y[j][3]); *(u32x2*)(orow + 4 * lane + 256 * j) = w; }
}
DI void row_load16(const bf16* row, int lane, f32x4 (&v)[4]) {
#pragma unroll
    for (int j = 0; j < 4; ++j) { const u32x2 w = *(const u32x2*)(row + 4 * lane + 256 * j); v[j] = (f32x4){bflo(w.x), bfhi(w.x), bflo(w.y), bfhi(w.y)}; }
}
DI void norm_first(Frame& F, const float* src, bf16* H16, float* rstd) {
    const int gw = F.bid * NWAVES + F.wave, NGW = F.G * NWAVES;
    for (int m = gw; m < T; m += NGW) { f32x4 v[4]; row_load(src + (size_t)m * D, F.lane, v); const float r = row_rstd(v);
        row_store_bf16(H16 + (size_t)m * D, F.lane, v); if (F.lane == 0) rstd[m] = r; }
}
DI void pb_convert(Frame& F, const float* p, bf16* PBo) {
    const size_t n8 = (size_t)2 * T * PLE / 8;
    for (size_t i = (size_t)F.bid * NTHR + F.tid; i < n8; i += (size_t)F.G * NTHR) { const f32x4 a = *(const f32x4*)(p + 8 * i), b = *(const f32x4*)(p + 8 * i + 4);
        u32x4 w; w.x = pk(a[0], a[1]); w.y = pk(a[2], a[3]); w.z = pk(b[0], b[1]); w.w = pk(b[2], b[3]); *(u32x4*)(PBo + 8 * i) = w; }
}
DI void norm_final(Frame& F, const bf16* H16, const float* gain, float* out) {
    f32x4 gv[4]; row_load(gain, F.lane, gv);
    const int gw = F.bid * NWAVES + F.wave, NGW = F.G * NWAVES;
    for (int m = gw; m < T; m += NGW) { f32x4 v[4]; row_load16(H16 + (size_t)m * D, F.lane, v); const float r = row_rstd(v);
#pragma unroll
        for (int j = 0; j < 4; ++j) *(f32x4*)(out + (size_t)m * D + 4 * F.lane + 256 * j) = v[j] * r * gv[j]; }
}
template <bool FROM_SS, class Sched> DI void fill_rtab(Frame& F, const Sched& S, LAS float* rtab, const float* src) {
    LAS int* ui = (LAS int*)(F.lds + UINFO_OFF);
    pg8::Unit u; int ns = 0, last = -1;
    for (int i = 0; S.next(i, u); ++i) if (u.pm != last) { last = u.pm; if (ns < 15 && F.tid == 0) ui[4 * ns + 3] = u.pm; ++ns; }
    __syncthreads();
    const int nsl = ns < 15 ? ns : 15, r = F.tid & 255, s0 = F.tid >> 8;
    for (int sb = 0; sb < nsl; sb += 8) {
        f32x4 q[4][4]; float rr[4];
#pragma unroll
        for (int j = 0; j < 4; ++j) { const int sl = sb + s0 + 2 * j; if (sl < nsl) { const size_t row = (size_t)ui[4 * sl + 3] * 256 + r;
            if (FROM_SS) { const f32x4* p = (const f32x4*)(src + row * 16); q[j][0] = p[0]; q[j][1] = p[1]; q[j][2] = p[2]; q[j][3] = p[3]; } else rr[j] = src[row]; } }
#pragma unroll
        for (int j = 0; j < 4; ++j) { const int sl = sb + s0 + 2 * j; if (sl < nsl) { float rv;
            if (FROM_SS) { const f32x4 a = q[j][0], b = q[j][1], c = q[j][2], d = q[j][3];
                float t = 0.f; t += a[0]; t += a[1]; t += a[2]; t += a[3]; t += b[0]; t += b[1]; t += b[2]; t += b[3]; t += c[0]; t += c[1]; t += c[2]; t += c[3]; t += d[0]; t += d[1]; t += d[2]; t += d[3];
                rv = 1.0f / sqrtf(t * (1.f / D) + EPS); }
            else rv = rr[j];
            rtab[sl * 256 + r] = rv; } }
    }
    __syncthreads();
}
DI float rstd_from_ss(const float* ss, int row) { const f32x4* p = (const f32x4*)(ss + (size_t)row * 16); const f32x4 a = p[0], b = p[1], c = p[2], d = p[3];
    float t = 0.f; t += a[0]; t += a[1]; t += a[2]; t += a[3]; t += b[0]; t += b[1]; t += b[2]; t += b[3]; t += c[0]; t += c[1]; t += c[2]; t += c[3]; t += d[0]; t += d[1]; t += d[2]; t += d[3];
    return 1.0f / sqrtf(t * (1.f / D) + EPS); }
DI void moe_combine(Frame& F, bf16* H16, unsigned char* G8, float* rstd, const unsigned char* YP, const int* tokrow, const float* tokinfo) {
    const int gw = F.bid * NWAVES + F.wave, NGW = F.G * NWAVES;
    for (int m = gw; m < T; m += NGW) { f32x4 v[4]; row_load16(H16 + (size_t)m * D, F.lane, v);
        const int r0 = tokrow[2 * m], r1 = tokrow[2 * m + 1]; const float w0 = tokinfo[4 * m + 2] * (1.0f / S8_Y), w1 = tokinfo[4 * m + 3] * (1.0f / S8_Y);
#pragma unroll
        for (int j = 0; j < 4; ++j) { const int a = *(const int*)(YP + (size_t)r0 * D + 4 * F.lane + 256 * j), b = *(const int*)(YP + (size_t)r1 * D + 4 * F.lane + 256 * j);
            const f32x2 a0 = __builtin_amdgcn_cvt_pk_f32_fp8(a, false), a1 = __builtin_amdgcn_cvt_pk_f32_fp8(a, true), b0 = __builtin_amdgcn_cvt_pk_f32_fp8(b, false), b1 = __builtin_amdgcn_cvt_pk_f32_fp8(b, true);
            v[j][0] += w0 * a0[0] + w1 * b0[0]; v[j][1] += w0 * a0[1] + w1 * b0[1]; v[j][2] += w0 * a1[0] + w1 * b1[0]; v[j][3] += w0 * a1[1] + w1 * b1[1]; }
        const float r = row_rstd(v);
        row_store_bf16(H16 + (size_t)m * D, F.lane, v); if (F.lane == 0) rstd[m] = r;
        if (F8_GATE) {
#pragma unroll
            for (int j = 0; j < 4; ++j) *(unsigned*)(G8 + (size_t)m * D + 4 * F.lane + 256 * j) = pk8(v[j][0] * S8_H, v[j][1] * S8_H, v[j][2] * S8_H, v[j][3] * S8_H); } }
}
DI void norm_router(Frame& F, const bf16* H16, const float* gain, const float* router, float* tokinfo, int* bcnt) {
    LAS int* sel = (LAS int*)(F.lds + 32768);
    LAS float* wts = (LAS float*)(F.lds + 32768 + 1024);
    LAS int* pib = (LAS int*)(F.lds + 32768 + 1024 + 2048);
    f32x4 gv[4]; row_load(gain, F.lane, gv);
    f32x4 rw[4][4][2];
#pragma unroll
    for (int j = 0; j < 4; ++j)
#pragma unroll
        for (int q = 0; q < 4; ++q) { const int c = 4 * F.lane + 256 * j + q; rw[j][q][0] = *(const f32x4*)(router + c * 8); rw[j][q][1] = *(const f32x4*)(router + c * 8 + 4); }
    for (int blk = F.bid; blk < T / 256; blk += F.G) {
        for (int i = 0; i < 32; ++i) { const int rl = F.wave * 32 + i, m = blk * 256 + rl; f32x4 v[4]; row_load16(H16 + (size_t)m * D, F.lane, v); const float r = row_rstd(v);
            float lg[NE];
#pragma unroll
            for (int e = 0; e < NE; ++e) lg[e] = 0.f;
#pragma unroll
            for (int j = 0; j < 4; ++j) { v[j] = v[j] * r * gv[j];
#pragma unroll
                for (int q = 0; q < 4; ++q) { const f32x4 r0 = rw[j][q][0], r1 = rw[j][q][1];
                    lg[0] += v[j][q] * r0[0]; lg[1] += v[j][q] * r0[1]; lg[2] += v[j][q] * r0[2]; lg[3] += v[j][q] * r0[3]; lg[4] += v[j][q] * r1[0]; lg[5] += v[j][q] * r1[1]; lg[6] += v[j][q] * r1[2]; lg[7] += v[j][q] * r1[3]; } }
#pragma unroll
            for (int e = 0; e < NE; ++e) lg[e] = wave_sum(lg[e]);
            int e0 = 0; float v0 = lg[0];
#pragma unroll
            for (int e = 1; e < NE; ++e) if (lg[e] > v0) { v0 = lg[e]; e0 = e; }
            int e1 = -1; float v1 = -3.0e38f;
#pragma unroll
            for (int e = 0; e < NE; ++e) if (e != e0 && lg[e] > v1) { v1 = lg[e]; e1 = e; }
            const float w0 = 1.f / (1.f + __expf(v1 - v0));
            if (F.lane == 0) { sel[rl] = e0 | (e1 << 8); wts[2 * rl] = w0; wts[2 * rl + 1] = 1.f - w0; }
        }
        __syncthreads();
        LAS int* p0 = pib; LAS int* p1 = pib + 256;
        if (F.tid < NE) { const int e = F.tid; int cnt = 0;
            for (int rl = 0; rl < 256; ++rl) { const int s = sel[rl]; if ((s & 255) == e) p0[rl] = cnt++; if ((s >> 8) == e) p1[rl] = cnt++; }
            bcnt[blk * NE + e] = cnt; }
        __syncthreads();
        if (F.tid < 256) { const int m = blk * 256 + F.tid; f32x4 o; o[0] = __int_as_float(sel[F.tid]); o[1] = __int_as_float(p0[F.tid] | (p1[F.tid] << 16)); o[2] = wts[2 * F.tid]; o[3] = wts[2 * F.tid + 1]; *(f32x4*)(tokinfo + 4 * (size_t)m) = o; }
        __syncthreads();
    }
}
DI void moe_index(Frame& F, const int* bcnt, const float* tokinfo, int* tokrow, int* rowtok, int* meta) {
    LAS int* C = (LAS int*)F.lds;
    LAS int* tot = C + 2048; LAS int* base = tot + 8; LAS int* off = base + 8;
    for (int i = F.tid; i < 2048; i += NTHR) C[i] = bcnt[i];
    __syncthreads();
    for (int blk = F.bid; blk < T / 256; blk += F.G) {
        if (F.tid < NE) { int t = 0, b = 0; for (int k = 0; k < 256; ++k) { const int c = C[k * NE + F.tid]; if (k < blk) b += c; t += c; } tot[F.tid] = t; base[F.tid] = b; }
        __syncthreads();
        if (F.tid == 0) { int o = 0; for (int e = 0; e < NE; ++e) { off[e] = o; o += (tot[e] + 255) & ~255; } off[NE] = o; }
        __syncthreads();
        if (F.tid < 256) { const int m = blk * 256 + F.tid; const f32x4 ti = *(const f32x4*)(tokinfo + 4 * (size_t)m); const int s = __float_as_int(ti[0]), pp = __float_as_int(ti[1]);
            const int e0 = s & 255, e1 = s >> 8; const int r0 = off[e0] + base[e0] + (pp & 0xffff), r1 = off[e1] + base[e1] + (pp >> 16);
            rowtok[r0] = m; rowtok[r1] = m; tokrow[2 * m] = r0; tokrow[2 * m + 1] = r1; }
        if (blk < NE) { const int e = blk; for (int r = tot[e] + F.tid; r < ((tot[e] + 255) & ~255); r += NTHR) rowtok[off[e] + r] = 0; }
        if (blk == 0) { const int np = off[NE] >> 8; if (F.tid == 0) meta[0] = np;
            for (int p = F.tid; p < np; p += NTHR) { int e = 0;
#pragma unroll
                for (int k = 1; k < NE; ++k) if (p * 256 >= off[k]) e = k;
                meta[16 + p] = e; } }
        __syncthreads();
    }
}

DI int slot_of(int key) { const int kl = key & 31; return (key & ~31) + 8 * ((kl >> 2) & 3) + 4 * (kl >> 4) + (kl & 3); }
DI float log2_gamma(int h) { return log2f(1.0f - exp2f(-5.0f - (float)h)); }
struct RetKV { u32x4 k[2], v[2]; };
DI void ret_kv_load(Frame& F, const bf16* Z, int unit, RetKV& r) {
    const int bh = unit >> 6, c = unit & 63, b = bh >> 3, h = bh & 7; const size_t row0 = (size_t)b * SEQ + c * 128;
#pragma unroll
    for (int i = 0; i < 2; ++i) { const int p = i * 512 + F.tid, m = p >> 3, ch = p & 7;
        r.k[i] = *(const u32x4*)(Z + (row0 + m) * ZP + Z_KR + h * 64 + 8 * ch); r.v[i] = *(const u32x4*)(Z + (row0 + m) * ZP + Z_VR + h * 64 + 8 * ch); }
}
DI void ret_kv_compute(Frame& F, float* RETS, int unit, const RetKV& r, bool has_next, const bf16* Z, int next_unit, RetKV& rn) {
    const int h = (unit >> 6) & 7; const float lg = log2_gamma(h);
    LAS unsigned char* KI = F.lds; LAS unsigned char* VI = F.lds + 16384;
#pragma unroll
    for (int i = 0; i < 2; ++i) { const int p = i * 512 + F.tid, m = p >> 3, ch = p & 7;
        const float sc = 0.125f * fexp2((float)(127 - m) * lg);
        u32x4 kk; kk.x = pk(bflo(r.k[i].x) * sc, bfhi(r.k[i].x) * sc); kk.y = pk(bflo(r.k[i].y) * sc, bfhi(r.k[i].y) * sc); kk.z = pk(bflo(r.k[i].z) * sc, bfhi(r.k[i].z) * sc); kk.w = pk(bflo(r.k[i].w) * sc, bfhi(r.k[i].w) * sc);
        const int o = m * 128 + (tr_chunk(m, ch) << 4); *(LAS u32x4*)(KI + o) = kk; *(LAS u32x4*)(VI + o) = r.v[i]; }
    __syncthreads();
    if (has_next) ret_kv_load(F, Z, next_unit, rn);
    const int fr = F.lane & 15, fq = F.lane >> 4;
#pragma unroll
    for (int tt = 0; tt < 2; ++tt) { const int tile = 2 * F.wave + tt, et = tile >> 2, dt = tile & 3; f32x4 acc = {0.f, 0.f, 0.f, 0.f};
#pragma unroll
        for (int ks = 0; ks < 4; ++ks) acc = MFMA16(tr_frag(VI, ks, et, fr, fq), tr_frag(KI, ks, dt, fr, fq), acc);
        float* o = RETS + ((size_t)unit * 64) * 64;
#pragma unroll
        for (int v = 0; v < 4; ++v) o[(16 * et + 4 * fq + v) * 64 + 16 * dt + fr] = acc[v]; }
    __syncthreads();
}
DI void ret_kv_units(Frame& F, const bf16* Z, float* RETS, int u0, int step, int n) {
    if (n <= 0) return;
    RetKV ra, rb; ret_kv_load(F, Z, u0, ra);
#pragma nounroll
    for (int i = 0; i < n; ++i) { ret_kv_compute(F, RETS, u0 + i * step, ra, i + 1 < n, Z, u0 + (i + 1) * step, rb); ra = rb; }
}
DI void ret_scan(Frame& F, float* RETS) {
    for (int e = F.bid * NTHR + F.tid; e < 64 * 4096; e += F.G * NTHR) { const int bh = e >> 12, idx = e & 4095, h = bh & 7; const float gc = fexp2(128.f * log2_gamma(h));
        float* p = RETS + (size_t)bh * 64 * 4096 + idx; float st = 0.f;
        for (int c0 = 0; c0 < 64; c0 += 8) { float kv[8];
#pragma unroll
            for (int j = 0; j < 8; ++j) kv[j] = p[(size_t)(c0 + j) * 4096];
#pragma unroll
            for (int j = 0; j < 8; ++j) { p[(size_t)(c0 + j) * 4096] = st; st = gc * st + kv[j]; } } }
}
DI void cmp_out(Frame& F, const bf16* HIDC, const float* w2  , bf16* KCMP, bf16* VCMPT) {
    LAS bf16* WT = (LAS bf16*)F.lds; const int fr = F.lane & 15, fq = F.lane >> 4; int have = -1;
    for (int rb = F.bid; rb < 16384 / 64; rb += F.G) { const int R0 = rb * 64, combo = R0 >> 12, which = combo >> 1, g = combo & 1;
        if (which != have) { __syncthreads();
#pragma unroll
            for (int i = 0; i < 8; ++i) { const int e = (i * 512 + F.tid) * 4, k = e >> 6, d0 = e & 63; const f32x4 w = *(const f32x4*)(w2 + (size_t)which * 16384 + e);
                const unsigned p0 = pk(w[0], w[1]), p1 = pk(w[2], w[3]); WT[(d0 + 0) * 264 + k] = (bf16)(p0 & 0xffff); WT[(d0 + 1) * 264 + k] = (bf16)(p0 >> 16); WT[(d0 + 2) * 264 + k] = (bf16)(p1 & 0xffff); WT[(d0 + 3) * 264 + k] = (bf16)(p1 >> 16); }
            have = which; __syncthreads(); }
        const int rt = F.wave & 3, row = R0 + 16 * rt + fr; f32x4 acc[2] = {{0.f, 0.f, 0.f, 0.f}, {0.f, 0.f, 0.f, 0.f}};
#pragma unroll
        for (int ks = 0; ks < 8; ++ks) { const bf16x8 a = *(const bf16x8*)(HIDC + (size_t)row * 256 + 32 * ks + 8 * fq);
#pragma unroll
            for (int c = 0; c < 2; ++c) { const int ct = 2 * (F.wave >> 2) + c; const bf16x8 bb = *(const LAS bf16x8*)(WT + (16 * ct + fr) * 264 + 32 * ks + 8 * fq); acc[c] = MFMA16(a, bb, acc[c]); } }
        const int rq = R0 + 16 * rt + 4 * fq, bn = rq & 4095, bq = bn >> 9, n0 = bn & 511, bg = bq * 2 + g;
#pragma unroll
        for (int c = 0; c < 2; ++c) { const int dd = 16 * (2 * (F.wave >> 2) + c) + fr; float v4[4];
#pragma unroll
            for (int v = 0; v < 4; ++v) v4[v] = (n0 + v == 511) ? 0.f : acc[c][v];
            if (which == 0) {
#pragma unroll
                for (int v = 0; v < 4; ++v) KCMP[((size_t)bg * 512 + n0 + v) * 64 + dd] = (bf16)(pk(v4[v], 0.f) & 0xffff); }
            else {
#pragma unroll
                for (int v = 0; v < 4; ++v) VCMPT[((size_t)bg * 512 + n0 + v) * 64 + dd] = (bf16)(pk(v4[v], 0.f) & 0xffff); } }
    }
    __syncthreads();
}

namespace rto { constexpr int RAWK = 0, RAWV = 32768, RAWS = 65536, STO = RAWS + 16384, END = STO + 64 * 72 * 2; static_assert(END <= RING_BYTES, "ret_out lds"); }
DI void ret_out_dma(Frame& F, const bf16* Z, const float* RETS, int unit, int kbuf) {
    const int bh = unit >> 6, c = unit & 63, b = bh >> 3, h = bh & 7; const size_t row0 = (size_t)b * SEQ + c * 128;
    const unsigned l0 = (unsigned)(uintptr_t)F.lds;
#pragma unroll
    for (int j = 0; j < 2; ++j) { const int p = 2 * F.wave + j, row = 8 * p + (F.lane >> 3), cl = F.lane & 7;
        gl16((const char*)(Z + (row0 + row) * ZP + Z_KR + h * 64) + ((cl ^ ((row >> 1) & 7)) << 4), (unsigned)__builtin_amdgcn_readfirstlane(l0 + rto::RAWK + kbuf * 16384 + p * 1024));
        gl16((const char*)(Z + (row0 + row) * ZP + Z_VR + h * 64) + (tr_chunk(row, cl) << 4), (unsigned)__builtin_amdgcn_readfirstlane(l0 + rto::RAWV + kbuf * 16384 + p * 1024));
        gl16((const char*)(RETS + (size_t)unit * 4096) + p * 1024 + F.lane * 16, (unsigned)__builtin_amdgcn_readfirstlane(l0 + rto::RAWS + p * 1024)); }
}
DI int ret_out_unit(Frame& F, const bf16* Z, const float* RETS, const float* gn, bf16* AR, int unit, int kbuf, unsigned* qctr, LAS int* qslot) {
    int grabbed = 0; if (F.tid == 0) grabbed = (int)__hip_atomic_fetch_add(qctr, 1u, __ATOMIC_RELAXED, __HIP_MEMORY_SCOPE_AGENT);
    const int bh = unit >> 6, c = unit & 63, b = bh >> 3, h = bh & 7; const float lg = log2_gamma(h);
    const LAS unsigned char* Kl = F.lds + rto::RAWK + kbuf * 16384;
    const LAS unsigned char* VI = F.lds + rto::RAWV + kbuf * 16384;
    LAS bf16* ST = (LAS bf16*)(F.lds + rto::STO);
    const size_t row0 = (size_t)b * SEQ + c * 128;
    const int fr = F.lane & 15, fq = F.lane >> 4, w = F.wave, n = 16 * w + fr;
    bf16x8 q[2];
#pragma unroll
    for (int ks = 0; ks < 2; ++ks) q[ks] = *(const bf16x8*)(Z + (row0 + n) * ZP + Z_QR + h * 64 + 32 * ks + 8 * fq);
    u32x2 gsave[4];
#pragma unroll
    for (int et = 0; et < 4; ++et) gsave[et] = *(const u32x2*)(Z + (row0 + n) * ZP + Z_GR + h * 64 + 16 * et + 4 * fq);
    __builtin_amdgcn_s_waitcnt(0);
    __syncthreads();
    { const int e = F.tid >> 3, d0 = (F.tid & 7) * 8; const f32x4 s0 = *(const LAS f32x4*)(F.lds + rto::RAWS + (e * 64 + d0) * 4), s1 = *(const LAS f32x4*)(F.lds + rto::RAWS + (e * 64 + d0 + 4) * 4);
      u32x4 wv; wv.x = pk(s0[0], s0[1]); wv.y = pk(s0[2], s0[3]); wv.z = pk(s1[0], s1[1]); wv.w = pk(s1[2], s1[3]); *(LAS u32x4*)(ST + e * 72 + d0) = wv; }
    if (F.tid == 0) qslot[0] = grabbed;
    asm volatile("s_waitcnt lgkmcnt(0)" ::: "memory");
    __syncthreads();
    const int nq = F.G + __builtin_amdgcn_readfirstlane(qslot[0]);
    if (nq < 2048 + 4096) ret_out_dma(F, Z, RETS, nq - 2048, kbuf ^ 1);
    f32x4 s[8];
#pragma unroll
    for (int mt = 0; mt < 8; ++mt) { s[mt] = (f32x4){0.f, 0.f, 0.f, 0.f};
        if (mt <= w) {
#pragma unroll
            for (int ks = 0; ks < 2; ++ks) { const bf16x8 a = *(const LAS bf16x8*)(Kl + (16 * mt + fr) * 128 + (((4 * ks + fq) ^ ((fr >> 1) & 7)) << 4)); s[mt] = MFMA16(a, q[ks], s[mt]); }
#pragma unroll
            for (int v = 0; v < 4; ++v) { const int m = 16 * mt + 4 * fq + v; const int df = n - m; s[mt][v] = (df >= 0) ? s[mt][v] * 0.125f * fexp2((float)df * lg) : 0.f; } } }
    f32x4 o1[4], o2[4];
#pragma unroll
    for (int et = 0; et < 4; ++et) { o1[et] = (f32x4){0.f, 0.f, 0.f, 0.f}; o2[et] = (f32x4){0.f, 0.f, 0.f, 0.f}; }
#pragma unroll
    for (int pg = 0; pg < 4; ++pg) if (2 * pg <= w) { const bf16x8 pb = mk8(pk(s[2 * pg][0], s[2 * pg][1]), pk(s[2 * pg][2], s[2 * pg][3]), pk(s[2 * pg + 1][0], s[2 * pg + 1][1]), pk(s[2 * pg + 1][2], s[2 * pg + 1][3]));
#pragma unroll
        for (int et = 0; et < 4; ++et) o1[et] = MFMA16(tr_frag(VI, pg, et, fr, fq), pb, o1[et]); }
#pragma unroll
    for (int ks = 0; ks < 2; ++ks)
#pragma unroll
        for (int et = 0; et < 4; ++et) { const bf16x8 a = *(const LAS bf16x8*)(ST + (16 * et + fr) * 72 + 32 * ks + 8 * fq); o2[et] = MFMA16(a, q[ks], o2[et]); }
    const float xi = fexp2((float)(n + 1) * lg);
    float sum = 0.f;
#pragma unroll
    for (int et = 0; et < 4; ++et) { o1[et] = o1[et] + o2[et] * xi; sum += (o1[et][0] + o1[et][1]) + (o1[et][2] + o1[et][3]); }
    sum += __shfl_xor(sum, 16); sum += __shfl_xor(sum, 32);
    const float mu = sum * (1.f / 64.f); float var = 0.f;
#pragma unroll
    for (int et = 0; et < 4; ++et) { o1[et] = o1[et] - mu; var += (o1[et][0] * o1[et][0] + o1[et][1] * o1[et][1]) + (o1[et][2] * o1[et][2] + o1[et][3] * o1[et][3]); }
    var += __shfl_xor(var, 16); var += __shfl_xor(var, 32);
    const float rs = 1.0f / sqrtf(var * (1.f / 64.f) + EPS);
#pragma unroll
    for (int et = 0; et < 4; ++et) { const int e0 = 16 * et + 4 * fq; const f32x4 gg = *(const f32x4*)(gn + h * 64 + e0); const u32x2 gr = gsave[et];
        const float y0 = o1[et][0] * rs * gg[0] * siluf_(bflo(gr.x)), y1 = o1[et][1] * rs * gg[1] * siluf_(bfhi(gr.x)), y2 = o1[et][2] * rs * gg[2] * siluf_(bflo(gr.y)), y3 = o1[et][3] * rs * gg[3] * siluf_(bfhi(gr.y));
        u32x2 wv; wv.x = pk(y0, y1); wv.y = pk(y2, y3); *(u32x2*)(AR + (row0 + n) * D + 512 + h * 64 + e0) = wv; }
    return nq - F.G;
}

namespace nsa {
constexpr int KP = 128, STG = 2 * 64 * KP, NSTG = 4;
constexpr int OFF_IMPA = NSTG * STG, OFF_IMPB = OFF_IMPA + 32768, OFF_SEL = OFF_IMPB + 32768, OFF_WU = OFF_SEL + 1024, NEED = OFF_WU + 128;
static_assert(NEED <= GTAB_OFF + 16384, "nsa lds");
constexpr float THR = 6.0f;
struct Ctx { LAS unsigned char* lds; const bf16* Z; const bf16* KCMP; const bf16* VCMPT; int tid, lane, wave, fr, fq, b, g, bg, cur; size_t tb; };
typedef unsigned long long u64;
struct M128 { u64 lo, hi; };
DI bool get_bit(const M128& w, int i) { const u64 x = (i < 64) ? w.lo : w.hi; return ((x >> (i & 63)) & 1ull) != 0ull; }
DI void set_bit(M128& w, int i) { const u64 b = 1ull << (i & 63); if (i < 64) w.lo |= b; else w.hi |= b; }
DI int last_bit(const M128& w, int upto) {
    if (upto < 0) return -1;
    u64 x = (upto >= 64) ? (w.hi & (~0ull >> (63 - (upto & 63)))) : 0ull;
    if (x) return 127 - __builtin_clzll(x);
    x = (upto >= 64) ? w.lo : (w.lo & (~0ull >> (63 - upto)));
    if (x) return 63 - __builtin_clzll(x);
    return -1;
}
typedef short s16x4 __attribute__((ext_vector_type(4)));
DI s16x4 vtr(const LAS unsigned char* p) { return __builtin_bit_cast(s16x4, __builtin_amdgcn_ds_read_tr16_b64_v4i16((LAS s16x4*)p)); }
DI float xq_max(float v) { auto a = __builtin_amdgcn_permlane16_swap(__float_as_uint(v), __float_as_uint(v), false, false); v = fmaxf(__uint_as_float(a[0]), __uint_as_float(a[1]));
    auto b = __builtin_amdgcn_permlane32_swap(__float_as_uint(v), __float_as_uint(v), false, false); return fmaxf(__uint_as_float(b[0]), __uint_as_float(b[1])); }
DI float xq_sum(float v) { auto a = __builtin_amdgcn_permlane16_swap(__float_as_uint(v), __float_as_uint(v), false, false); v = __uint_as_float(a[0]) + __uint_as_float(a[1]);
    auto b = __builtin_amdgcn_permlane32_swap(__float_as_uint(v), __float_as_uint(v), false, false); return __uint_as_float(b[0]) + __uint_as_float(b[1]); }
DI float quad_sum(float v) { v += __int_as_float(__builtin_amdgcn_mov_dpp(__float_as_int(v), 0xB1, 0xf, 0xf, true)); v += __int_as_float(__builtin_amdgcn_mov_dpp(__float_as_int(v), 0x4E, 0xf, 0xf, true)); return v; }
DI void glds16(const void* gsrc, unsigned lds_dst) { unsigned keep;
    asm volatile("s_mov_b32 %0, m0\n\ts_mov_b32 m0, %2\n\ts_nop 0\n\tglobal_load_lds_dwordx4 %1, off\n\ts_mov_b32 m0, %0" : "=&s"(keep) : "v"(gsrc), "s"(lds_dst) : "memory"); }
template <int MODE> DI void src_ptrs(const Ctx& X, int m, const char*& kp, size_t& kpitch, const char*& vp) {
    if (MODE <= 1) { kp = (const char*)(X.KCMP + ((size_t)X.bg * 512 + 64 * m) * 64); kpitch = 128; vp = (const char*)(X.VCMPT + ((size_t)X.bg * 512 + 64 * m) * 64); }
    else if (MODE == 2) { kp = (const char*)(X.Z + (X.tb + 64 * m) * ZP + Z_KS + 64 * X.g); kpitch = (size_t)ZP * 2; vp = (const char*)(X.Z + (X.tb + 64 * m) * ZP + Z_VS + 64 * X.g); }
    else { kp = (const char*)(X.Z + (X.tb + 64 * m) * ZP + Z_KW + 64 * X.g); kpitch = (size_t)ZP * 2; vp = (const char*)(X.Z + (X.tb + 64 * m) * ZP + Z_VW + 64 * X.g); }
}
template <int MODE, bool MASKED>
DI void cg_block(const bf16x8 (&kf)[4][2], const bf16x8 (&q)[2], const f32x4& base0, float sl2, float kpos0, int fq4, int lim, bool inv, bool selbit,
                 float& mr, float& lr, f32x4 (&o)[4], bf16x8 (&pb)[2], LAS float* impA, LAS float* impB, int mg0, bool impw, int fr, int fq) {
    const bool use = (MODE == 2) ? selbit : true;
    const float kstep = sl2 * ((MODE <= 1) ? 256.f : 16.f);
    const float blk = use ? (sl2 * kpos0 - mr) : -__builtin_inff();
    f32x4 s[4];
#pragma unroll
    for (int kt = 0; kt < 4; ++kt) { s[kt] = base0 + (blk + kstep * (float)kt);
        if (MASKED) {
#pragma unroll
            for (int v = 0; v < 4; ++v) s[kt][v] = (((16 * kt + fq4 + v) <= lim) != inv) ? s[kt][v] : -__builtin_inff(); }
#pragma unroll
        for (int ks = 0; ks < 2; ++ks) s[kt] = MFMA16(kf[kt][ks], q[ks], s[kt]); }
    f32x2 ps2 = {0.f, 0.f};
#pragma unroll
    for (int kt = 0; kt < 4; ++kt) {
#pragma unroll
        for (int v = 0; v < 4; ++v) s[kt][v] = fexp2(s[kt][v]);
        ps2 = ps2 + (f32x2){s[kt][0], s[kt][1]} + (f32x2){s[kt][2], s[kt][3]};
        if (MODE == 1) { const float A = quad_sum((s[kt][0] + s[kt][1]) + (s[kt][2] + s[kt][3])), B = quad_sum(s[kt][3]);
            if (impw) { impA[mg0 + 4 * kt] = A; if ((mg0 & 127) + 4 * kt + 1 < 128) impB[mg0 + 4 * kt + 1] = B; } } }
    if (MODE != 1) lr += ps2.x + ps2.y;
    if (MODE != 0) {
#pragma unroll
        for (int kg = 0; kg < 2; ++kg) pb[kg] = mk8(pk(s[2 * kg][0], s[2 * kg][1]), pk(s[2 * kg][2], s[2 * kg][3]), pk(s[2 * kg + 1][0], s[2 * kg + 1][1]), pk(s[2 * kg + 1][2], s[2 * kg + 1][3])); }
}
template <int MODE> DI bool blk_masked(int m, int cur) { return (MODE <= 1) ? (64 * m + 63 > 4 * cur - 2) : (MODE == 2 ? (m == cur) : (m == cur || m == cur - 8)); }
template <int MODE>
DI void do_block(const Ctx& X, int m, int st, const bf16x8 (&q)[2][2], const int (&tq)[2], float sl2, const f32x4& base, int xfr, int xfq,
                 float (&mr)[2], float (&lr)[2], f32x4 (&o)[2][4], const M128& cgU0, const M128& cgU1, const M128& selw0, const M128& selw1) {
    const int cur = X.cur, fq4 = 4 * xfq;
    LAS float* impA = (LAS float*)(X.lds + OFF_IMPA); LAS float* impB = (LAS float*)(X.lds + OFF_IMPB);
    const bool needw = (MODE == 2) ? (get_bit(cgU0, m) || get_bit(cgU1, m)) : true;
    if (!needw) return;
    const LAS unsigned char* Kl = X.lds + st * STG; const LAS unsigned char* Vl = Kl + 64 * KP;
    const bool inv = (MODE == 3) && (m == cur - 8);
    const float kpos0 = (MODE <= 1) ? (float)(1024 * m + 31) : (float)(64 * m);
    const bool masked = blk_masked<MODE>(m, cur);
    bf16x8 kf[4][2];
#pragma unroll
    for (int kt = 0; kt < 4; ++kt)
#pragma unroll
        for (int ks = 0; ks < 2; ++ks) kf[kt][ks] = *(const LAS bf16x8*)(Kl + (16 * kt + xfr) * KP + (((4 * ks + xfq) ^ ((xfr >> 1) & 7)) << 4));
    bf16x8 pb[2][2];
#pragma unroll
    for (int cg = 0; cg < 2; ++cg) {
        const int lim = (MODE <= 1) ? (((tq[cg] - 31) >> 4) - 64 * m) : (tq[cg] - 64 * cur);
        const bool selbit = (MODE == 2) ? get_bit(cg == 0 ? selw0 : selw1, m) : true;
        const int tokl = 8 * X.wave + 4 * cg + (xfr >> 2); const int mg0 = tokl * 128 + 16 * m + xfq; const bool impw = (xfr & 3) == 0;
        if (masked) cg_block<MODE, true>(kf, q[cg], base, sl2, kpos0, fq4, lim, inv, selbit, mr[cg], lr[cg], o[cg], pb[cg], impA, impB, mg0, impw, xfr, xfq);
        else cg_block<MODE, false>(kf, q[cg], base, sl2, kpos0, fq4, lim, inv, selbit, mr[cg], lr[cg], o[cg], pb[cg], impA, impB, mg0, impw, xfr, xfq);
    }
    if (MODE != 0) {
#pragma unroll
        for (int kg = 0; kg < 2; ++kg)
#pragma unroll
            for (int dt = 0; dt < 4; ++dt) {
                const LAS unsigned char* vp0 = Vl + (4 * xfq + (xfr >> 2)) * KP + kg * 4096 + ((dt ^ ((2 * (xfq & 1) + (xfr >> 3)) & 3)) << 5) + ((xfr & 3) << 3);
                const s16x4 lo = vtr(vp0), hi = vtr(vp0 + 2048);
                const bf16x8 a = (bf16x8){lo[0], lo[1], lo[2], lo[3], hi[0], hi[1], hi[2], hi[3]};
                o[0][dt] = MFMA16(a, pb[0][kg], o[0][dt]); o[1][dt] = MFMA16(a, pb[1][kg], o[1][dt]); } }
}
template <int MODE> DI void dma_blk(const Ctx& X, int m, int stg, int ln) {
    const char* kp; size_t kpitch; const char* vp; src_ptrs<MODE>(X, m, kp, kpitch, vp);
    const int drow = 8 * X.wave + (ln >> 3), dch = ((ln & 7) ^ ((drow >> 1) & 7)) << 4;
    const unsigned lds0 = (unsigned)(uintptr_t)X.lds + (unsigned)X.wave * 1024u + (unsigned)stg * STG;
    glds16(kp + (unsigned)(drow * ((MODE <= 1) ? 128 : ZP * 2) + dch), (unsigned)__builtin_amdgcn_readfirstlane(lds0));
    const int dchv = ((ln & 7) ^ (2 * ((drow >> 1) & 3))) << 4;
    glds16(vp + (unsigned)(drow * ((MODE <= 1) ? 128 : ZP * 2) + dchv), (unsigned)__builtin_amdgcn_readfirstlane(lds0 + 8192u));
}
template <int MODE, int NMODE>
DI void run_blocks(const Ctx& X, const Ctx& XN, const M128& bm, const bf16x8 (&q)[2][2], const int (&tq)[2], float sl2, float (&mr)[2], float (&lr)[2], f32x4 (&o)[2][4],
                   const M128& cgU0, const M128& cgU1, const M128& selw0, const M128& selw1, int& hb, bool pre, int p0, int p1) {
    int ln_ = X.lane; asm volatile("" : "+v"(ln_));
    const int xfr = ln_ & 15, xfq = ln_ >> 4, fq4 = 4 * xfq;
    f32x4 base;
#pragma unroll
    for (int v = 0; v < 4; ++v) base[v] = sl2 * ((MODE <= 1) ? 16.f : 1.f) * (float)(fq4 + v);
    int m0 = last_bit(bm, 127), m1 = last_bit(bm, m0 - 1);
    while (m0 >= 0) {
        const int n0 = (m1 >= 0) ? last_bit(bm, m1 - 1) : -1, n1 = last_bit(bm, n0 - 1);
        asm volatile("s_waitcnt vmcnt(0) lgkmcnt(0)\n\ts_barrier" ::: "memory");
        if (n0 >= 0) { dma_blk<MODE>(X, n0, 2 * (hb ^ 1), ln_); if (n1 >= 0) dma_blk<MODE>(X, n1, 2 * (hb ^ 1) + 1, ln_); }
        else if (pre) { dma_blk<NMODE>(XN, p0, 2 * (hb ^ 1), ln_); if (p1 >= 0) dma_blk<NMODE>(XN, p1, 2 * (hb ^ 1) + 1, ln_); }
        do_block<MODE>(X, m0, 2 * hb, q, tq, sl2, base, xfr, xfq, mr, lr, o, cgU0, cgU1, selw0, selw1);
        if (m1 >= 0) do_block<MODE>(X, m1, 2 * hb + 1, q, tq, sl2, base, xfr, xfq, mr, lr, o, cgU0, cgU1, selw0, selw1);
        if (MODE != 1) {
#pragma unroll
            for (int cg = 0; cg < 2; ++cg) if (__any(lr[cg] > 0x1p60f)) { mr[cg] += 64.f; lr[cg] *= 0x1p-64f;
                if (MODE != 0) {
#pragma unroll
                    for (int dt = 0; dt < 4; ++dt) o[cg][dt] = o[cg][dt] * 0x1p-64f; } } }
        m0 = n0; m1 = n1; hb ^= 1;
    }
}
DI void make_ctx(Ctx& X, Frame& F, const bf16* Z, const bf16* KCMP, const bf16* VCMPT, int u) {
    X.lds = F.lds; X.Z = Z; X.KCMP = KCMP; X.VCMPT = VCMPT; X.tid = F.tid; X.lane = F.lane; X.wave = F.wave; X.fr = F.lane & 15; X.fq = F.lane >> 4;
    X.bg = u & 15; X.b = X.bg >> 1; X.g = X.bg & 1; X.cur = 127 - (u >> 4); X.tb = (size_t)X.b * SEQ;
}
constexpr int NQ = 2048;
DI int unit(Frame& F, const bf16* Z, const bf16* KCMP, const bf16* VCMPT, bf16* AR, int u, int& hb, unsigned* qctr, LAS int* qslot) {
    Ctx X, XN; make_ctx(X, F, Z, KCMP, VCMPT, u);
    int grabbed = 0; if (F.tid == 0) grabbed = (int)__hip_atomic_fetch_add(qctr, 1u, __ATOMIC_RELAXED, __HIP_MEMORY_SCOPE_AGENT);
    const int cur = X.cur, t0 = 64 * cur, r = X.fr & 3, head = 4 * X.g + r;
    const float sl2 = exp2f(-(float)(head + 1)) * LOG2E;
    int tq[2]; bf16x8 q[2][2]; float gate[2][3];
#pragma unroll
    for (int cg = 0; cg < 2; ++cg) { tq[cg] = t0 + 8 * X.wave + 4 * cg + (X.fr >> 2); const bf16* zr = Z + (X.tb + tq[cg]) * ZP;
#pragma unroll
        for (int ks = 0; ks < 2; ++ks) { const u32x4 w = *(const u32x4*)(zr + Z_QN + head * 64 + 32 * ks + 8 * X.fq); constexpr float C1 = 0.125f * LOG2E;
            q[cg][ks] = mk8(pk(bflo(w.x) * C1, bfhi(w.x) * C1), pk(bflo(w.y) * C1, bfhi(w.y) * C1), pk(bflo(w.z) * C1, bfhi(w.z) * C1), pk(bflo(w.w) * C1, bfhi(w.w) * C1)); }
#pragma unroll
        for (int br = 0; br < 3; ++br) gate[cg][br] = sigmoidf_(bf2f(zr[Z_GL + br * 8 + head])); }
    __builtin_amdgcn_s_waitcnt(0);
    f32x4 o[2][4]; float mr[2], lr[2];
    LAS f32x4* FIN = (LAS f32x4*)(X.lds + OFF_IMPA + X.wave * 8192) + X.lane;
    M128 cgU0 = {0ull, 0ull}, cgU1 = {0ull, 0ull}, selw0 = {0ull, 0ull}, selw1 = {0ull, 0ull}, bm;
    { const int jmax = (4 * cur + 2) >> 6; bm.lo = (2ull << jmax) - 1ull; bm.hi = 0ull; }
#pragma unroll
    for (int cg = 0; cg < 2; ++cg) { mr[cg] = sl2 * (float)tq[cg]; lr[cg] = 0.f;
#pragma unroll
        for (int dt = 0; dt < 4; ++dt) o[cg][dt] = (f32x4){0.f, 0.f, 0.f, 0.f}; }
    const int jm = (4 * cur + 2) >> 6;
    run_blocks<0, 1>(X, X, bm, q, tq, sl2, mr, lr, o, cgU0, cgU1, selw0, selw1, hb, true, jm, jm - 1);
#pragma unroll
    for (int cg = 0; cg < 2; ++cg) { const float lt = xq_sum(lr[cg]); mr[cg] = lt > 0.f ? mr[cg] + log2f(lt) : __builtin_inff(); }
    run_blocks<1, 2>(X, X, bm, q, tq, sl2, mr, lr, o, cgU0, cgU1, selw0, selw1, hb, true, cur, cur - 1);
#pragma unroll
    for (int cg = 0; cg < 2; ++cg)
#pragma unroll
        for (int dt = 0; dt < 4; ++dt) o[cg][dt] = o[cg][dt] * gate[cg][0];
    asm volatile("s_waitcnt lgkmcnt(0)" ::: "memory");
    {
        const LAS float* IA = (const LAS float*)(X.lds + OFF_IMPA); const LAS float* IB = (const LAS float*)(X.lds + OFF_IMPB); LAS u64* SEL = (LAS u64*)(X.lds + OFF_SEL);
        const int nforced = cur == 0 ? 1 : (cur == 1 ? 2 : 3), KK = 16 - nforced, ncand = cur - 2 > 0 ? cur - 2 : 0;
        M128 forced = {1ull, 0ull}; set_bit(forced, cur); if (cur >= 1) set_bit(forced, cur - 1);
        const int m0 = X.lane, m1 = X.lane + 64; const bool c0 = (m0 >= 1 && m0 <= cur - 2), c1 = (m1 <= cur - 2);
        M128 wu = {0ull, 0ull};
#pragma unroll 4
        for (int ti = 0; ti < 8; ++ti) { const int tok = 8 * X.wave + ti;
            const unsigned k0 = c0 ? (__float_as_uint(IA[tok * 128 + m0] + IB[tok * 128 + m0]) + 1u) : 0u, k1 = c1 ? (__float_as_uint(IA[tok * 128 + m1] + IB[tok * 128 + m1]) + 1u) : 0u;
            bool s0 = c0, s1 = c1;
            if (ncand > KK) { unsigned thr = 0u;
                for (int bit = 30; bit >= 0; --bit) { const unsigned cand = thr | (1u << bit); const int cnt = __popcll(__ballot(k0 >= cand)) + __popcll(__ballot(k1 >= cand)); if (cnt >= KK) { thr = cand; if (cnt == KK) break; } }
                const u64 g0 = __ballot(k0 > thr), g1 = __ballot(k1 > thr), e0 = __ballot(k0 == thr && c0), e1 = __ballot(k1 == thr && c1);
                const int needn = KK - (__popcll(g0) + __popcll(g1)); const u64 lt = (1ull << X.lane) - 1ull;
                const int rk0 = __popcll(e0 & lt), rk1 = __popcll(e0) + __popcll(e1 & lt);
                s0 = (k0 > thr) || (k0 == thr && c0 && rk0 < needn); s1 = (k1 > thr) || (k1 == thr && c1 && rk1 < needn); }
            const u64 wlo = __ballot(s0) | forced.lo, whi = __ballot(s1) | forced.hi;
            if (X.lane == 0) { SEL[tok * 2] = wlo; SEL[tok * 2 + 1] = whi; }
            if (ti < 4) { cgU0.lo |= wlo; cgU0.hi |= whi; } else { cgU1.lo |= wlo; cgU1.hi |= whi; }
            wu.lo |= wlo; wu.hi |= whi; }
        if (X.lane == 0) { ((LAS u64*)(X.lds + OFF_WU))[X.wave * 2] = wu.lo; ((LAS u64*)(X.lds + OFF_WU))[X.wave * 2 + 1] = wu.hi; }
        asm volatile("s_waitcnt lgkmcnt(0)" ::: "memory");
        { const int tl0 = 8 * X.wave + (X.fr >> 2), tl1 = tl0 + 4; selw0.lo = SEL[tl0 * 2]; selw0.hi = SEL[tl0 * 2 + 1]; selw1.lo = SEL[tl1 * 2]; selw1.hi = SEL[tl1 * 2 + 1]; }
        if (F.tid == 0) qslot[0] = grabbed;
        __syncthreads();
        #pragma unroll
        for (int cg = 0; cg < 2; ++cg)
#pragma unroll
            for (int dt = 0; dt < 4; ++dt) FIN[(cg * 4 + dt) * 64] = o[cg][dt];
        bm.lo = 0ull; bm.hi = 0ull;
#pragma unroll
        for (int w = 0; w < 8; ++w) { bm.lo |= ((const LAS u64*)(X.lds + OFF_WU))[w * 2]; bm.hi |= ((const LAS u64*)(X.lds + OFF_WU))[w * 2 + 1]; }
        bm.lo = ((u64)__builtin_amdgcn_readfirstlane((unsigned)(bm.lo >> 32)) << 32) | (u64)__builtin_amdgcn_readfirstlane((unsigned)bm.lo);
        bm.hi = ((u64)__builtin_amdgcn_readfirstlane((unsigned)(bm.hi >> 32)) << 32) | (u64)__builtin_amdgcn_readfirstlane((unsigned)bm.hi);
    }
    const int un = F.G + __builtin_amdgcn_readfirstlane(qslot[0]);
    make_ctx(XN, F, Z, KCMP, VCMPT, un < NQ ? un : u);
#pragma unroll
    for (int cg = 0; cg < 2; ++cg) { mr[cg] = sl2 * (float)tq[cg]; lr[cg] = 0.f;
#pragma unroll
        for (int dt = 0; dt < 4; ++dt) o[cg][dt] = (f32x4){0.f, 0.f, 0.f, 0.f}; }
    run_blocks<2, 3>(X, X, bm, q, tq, sl2, mr, lr, o, cgU0, cgU1, selw0, selw1, hb, true, cur, cur - 1);
#pragma unroll
    for (int cg = 0; cg < 2; ++cg) { const float lt = xq_sum(lr[cg]); const float sc = (lt > 0.f ? 1.0f / lt : 0.f) * gate[cg][1];
#pragma unroll
        for (int dt = 0; dt < 4; ++dt) FIN[(cg * 4 + dt) * 64] = FIN[(cg * 4 + dt) * 64] + o[cg][dt] * sc; }
    bm.lo = 0ull; bm.hi = 0ull;
    for (int mm = (cur >= 8 ? cur - 8 : 0); mm <= cur; ++mm) set_bit(bm, mm);
#pragma unroll
    for (int cg = 0; cg < 2; ++cg) { mr[cg] = sl2 * (float)tq[cg]; lr[cg] = 0.f;
#pragma unroll
        for (int dt = 0; dt < 4; ++dt) o[cg][dt] = (f32x4){0.f, 0.f, 0.f, 0.f}; }
    { const int jn = (4 * XN.cur + 2) >> 6; run_blocks<3, 0>(X, XN, bm, q, tq, sl2, mr, lr, o, cgU0, cgU1, selw0, selw1, hb, un < NQ, jn, jn - 1); }
#pragma unroll
    for (int cg = 0; cg < 2; ++cg) { const float lt = xq_sum(lr[cg]); const float sc = (lt > 0.f ? 1.0f / lt : 0.f) * gate[cg][2];
        bf16* orow = AR + (X.tb + tq[cg]) * D + head * 64;
#pragma unroll
        for (int dt = 0; dt < 4; ++dt) { const f32x4 y = FIN[(cg * 4 + dt) * 64] + o[cg][dt] * sc; u32x2 wv; wv.x = pk(y[0], y[1]); wv.y = pk(y[2], y[3]); *(u32x2*)(orow + 16 * dt + 4 * X.fq) = wv; } }
    return un - F.G;
}
}

__global__ void __launch_bounds__(NTHR, 2) hybrid_fwd(Args args) {
    extern __shared__ __attribute__((aligned(16))) unsigned char lds_raw[];
    Frame F; F.lds = (LAS unsigned char*)lds_raw; F.ws = args.ws; F.tid = threadIdx.x; F.lane = F.tid & 63; F.wave = __builtin_amdgcn_readfirstlane(F.tid >> 6); F.wave0 = F.wave; F.G = gridDim.x; F.bid = blockIdx.x;
    volatile LAS unsigned* MISC = (volatile LAS unsigned*)(F.lds + MISC_OFF);
    if (F.tid < 32) MISC[F.tid] = 0u;
    __syncthreads();
    unsigned* ctl = (unsigned*)(args.ws + WS_CTL);
    XcdBarrier bar = xcd_barrier_post(ctl + 4096, MISC + 8, F.wave0);
    unsigned char* ws = args.ws;
#define RELAUNDER() do { relaunder(F); GAS unsigned char* wsg_ = (GAS unsigned char*)ws; asm volatile("" : "+s"(wsg_)); ws = (unsigned char*)wsg_; F.ws = ws; } while (0)
#define P16 ((bf16*)args.out)
#define Q16 (((bf16*)args.out) + (size_t)T * D)
#define H16C ((bf16*)(ws + WS_Z + 128 * MiB))
#define HL (L == 0 ? P16 : Q16)
#define Zb ((bf16*)(ws + WS_Z))
#define AR ((bf16*)(ws + WS_AR))
#define RETS ((float*)(ws + WS_RETS))
#define VST ((bf16*)(ws + WS_VST))
#define VWT ((bf16*)(ws + WS_VWT))
#define HIDC ((bf16*)(ws + WS_HIDC))
#define KCMP ((bf16*)(ws + WS_KCMP))
#define VCMPT ((bf16*)(ws + WS_VCMPT))
#define POSB ((float*)(ws + WS_POSB))
#define BCNT ((int*)(ws + WS_BCNT))
#define META ((int*)(ws + WS_META))
#define TOKINFO ((float*)(ws + WS_TOKINFO))
#define TOKROW ((int*)(ws + WS_TOKROW))
#define ROWTOK ((int*)(ws + WS_ROWTOK))
#define RSTD ((float*)(ws + WS_RSTD))
#define SSA ((float*)(ws + WS_SSA))
#define SSB ((float*)(ws + WS_SSB))
#define HID8 ((unsigned char*)(ws + WS_HID))
#define H8 ((unsigned char*)(ws + WS_XN))
#define YP ((bf16*)(ws + WS_YP))
#define YP8 ((unsigned char*)(ws + WS_YP))
#define PP ((bf16*)(ws + WS_PP))
#define SIG8 ((unsigned char*)(ws + WS_PP))
#define PBALL ((bf16*)(ws + WS_PBALL))
    const LAS int* gtab = (const LAS int*)(F.lds + GTAB_OFF); LAS int* uinfo = (LAS int*)(F.lds + UINFO_OFF);
    LAS float* rtab = (LAS float*)(F.lds + RTAB_OFF);

    PH(0) {
        LAS float* scr = (LAS float*)(F.lds + F.wave * 16384);
        const int gw = F.bid * NWAVES + F.wave, NGW = F.G * NWAVES;
        for (int s = 0; s < NSEG; ++s) { const Seg g = seg_decode(args, s); const int nit = (g.K / 64) * (g.ncols / 32);
            for (int it = gw; it < nit; it += 2 * NGW) { f32x4 r0[8], r1[8]; const int it1 = it + NGW; transpose_load(g, it, F.lane, r0); if (it1 < nit) transpose_load(g, it1, F.lane, r1);
                transpose_store(g, scr, it, F.lane, r0); if (it1 < nit) transpose_store(g, scr, it1, F.lane, r1); } }
        __syncthreads();
        if (F.bid < 32) { const int hl = F.tid & 31, kg = F.tid >> 5, oi = F.bid * 32 + hl, lw = oi >> 8, hcol = oi & 255;
            const float* pos = args.in[I_CPOS] + (size_t)lw * 2048 + kg * 128; const float* w1 = args.in[I_CW1] + (size_t)lw * 2048 * 256 + (size_t)kg * 128 * 256 + hcol; float a = 0.f;
#pragma unroll 8
            for (int k = 0; k < 128; ++k) a += pos[k] * w1[(size_t)k * 256];
            LAS float* red = (LAS float*)F.lds; red[kg * 32 + hl] = a; __syncthreads();
            if (F.tid < 32) { float t = 0.f;
#pragma unroll
                for (int j = 0; j < 16; ++j) t += red[j * 32 + F.tid]; POSB[F.bid * 32 + F.tid] = t; }
            __syncthreads(); }
        norm_first(F, args.in[I_X], P16, RSTD);
        pb_convert(F, args.in[I_P], PBALL);
    }
    xcd_barrier(bar, F.wave0); RELAUNDER();

    for (int L = 0; L < 2; ++L) {
        unsigned char* wl = ws + WS_W + (size_t)L * WL_STRIDE;
        PH(1) {
          if (F8_IN1 && L == 1) { pg8::Gemm g{(const bf16*)(ws + WS_AR), (const bf16*)(wl + WL_WIN), D / 2, D / 2, 128}; pg8::StaticOrder S; S.init(T / 256, ZP / 256, F.G, F.bid, (size_t)256 * D, (size_t)256 * D);
            pg8::EpiBf16<0, ST_MODE> E{Zb, ZP, nullptr, 0, 1.0f / (S8_H * S8_WU), IN_COLS}; fill_rtab<true>(F, S, rtab, SSA);
            pg8::gemm_phase<pg8::EpiBf16<0, ST_MODE>, pg8::StaticOrder, false, 1, true>(F.tid, F.lds, g, S, E, gtab, rtab); }
          else { pg8::Gemm g{HL, (const bf16*)(wl + WL_WIN), D, D, 128}; pg8::StaticOrder S; S.init(T / 256, ZP / 256, F.G, F.bid, (size_t)256 * D * 2, (size_t)256 * D * 2);
            pg8::EpiBf16<0, ST_MODE> E{Zb, ZP, nullptr, 0, 1.0f, IN_COLS};
            if (L == 0) fill_rtab<false>(F, S, rtab, RSTD); else fill_rtab<true>(F, S, rtab, SSA);
            pg8::gemm_phase<pg8::EpiBf16<0, ST_MODE>, pg8::StaticOrder, false, 1>(F.tid, F.lds, g, S, E, gtab, rtab); } }
        xcd_barrier(bar, F.wave0); RELAUNDER();
        PH(2) { pg8::Gemm g{Zb, (const bf16*)(wl + WL_CW1), 2048, 16 * ZP, ZP * 2}; pg8::CmpOrder S{F.G, F.bid};
          pg8::EpiBf16<2> E{HIDC, 256, POSB + L * 512, 5}; pg8::gemm_phase<pg8::EpiBf16<2>, pg8::CmpOrder, false>(F.tid, F.lds, g, S, E, gtab); }
        __syncthreads();
        PH(4) {
          if (F.G == 256) { const int w = F.bid - 64; ret_kv_units(F, Zb, RETS, w * 21 + (w < 64 ? w : 64), 1, w < 0 ? 0 : 21 + (w < 64 ? 1 : 0)); }
          else ret_kv_units(F, Zb, RETS, F.bid, F.G, (4096 - F.bid + F.G - 1) / F.G); }
        xcd_barrier(bar, F.wave0); RELAUNDER();
        PH(5) cmp_out(F, HIDC, args.in[I_CW2] + (size_t)L * 2 * 256 * 64, KCMP, VCMPT);
        PH(6) ret_scan(F, RETS);
        xcd_barrier(bar, F.wave0); RELAUNDER();
        {
          int hb = 0; unsigned* qctr = ctl + 8192 + 64 * L; LAS int* qslot = (LAS int*)(F.lds + MISC_OFF) + 16; int u = F.bid; const float* gnp = args.in[I_RETGN] + (size_t)L * 512;
          if (u < nsa::NQ) { nsa::Ctx X0; nsa::make_ctx(X0, F, Zb, KCMP, VCMPT, u); const int jm = (4 * X0.cur + 2) >> 6; nsa::dma_blk<0>(X0, jm, 0, F.lane); if (jm >= 1) nsa::dma_blk<0>(X0, jm - 1, 1, F.lane); }
#pragma nounroll
          while (u < nsa::NQ) u = F.G + nsa::unit(F, Zb, KCMP, VCMPT, AR, u, hb, qctr, qslot);
          __syncthreads();
          if (u < nsa::NQ + 4096) ret_out_dma(F, Zb, RETS, u - nsa::NQ, 0);
          int kb = 0;
#pragma nounroll
          while (u < nsa::NQ + 4096) { u = F.G + ret_out_unit(F, Zb, RETS, gnp, AR, u - nsa::NQ, kb, qctr, qslot); kb ^= 1; }
          __syncthreads(); }
        xcd_barrier(bar, F.wave0); RELAUNDER();
        PH(9) { pg8::Gemm g{AR, (const bf16*)(wl + WL_WOUT), D, D, 128}; pg8::StaticOrder S; S.init(T / 256, D / 256, F.G, F.bid, (size_t)256 * D * 2, (size_t)256 * D * 2);
          if (L == 0) { pg8::EpiRes16<(F8_DUP != 0)> E{P16, P16, SSA, H8, 1.0f}; pg8::gemm_phase<pg8::EpiRes16<(F8_DUP != 0)>, pg8::StaticOrder, false>(F.tid, F.lds, g, S, E, gtab); }
          else { pg8::EpiRes16<true> E{Q16, Q16, SSA, H8, 1.0f}; pg8::gemm_phase<pg8::EpiRes16<true>, pg8::StaticOrder, false>(F.tid, F.lds, g, S, E, gtab); } }
        xcd_barrier(bar, F.wave0); RELAUNDER();
        if (L == 0) {
            constexpr int FCH = 128;
            for (int ch = 0; ch < (T / 256) / FCH; ++ch) {
                PH(11) {
#if F8_DUP
                  pg8::Gemm g{(const bf16*)H8, (const bf16*)(ws + WS_WDENSE), D / 2, D / 2, 128}; pg8::StaticOrder S; S.init(FCH, 2 * DFF / 256, F.G, F.bid, (size_t)256 * D, (size_t)256 * D, ch * FCH); const float usc = 1.0f / (S8_H * S8_WU);
#else
                  pg8::Gemm g{P16, (const bf16*)(ws + WS_WDENSE), D, D, 128}; pg8::StaticOrder S; S.init(FCH, 2 * DFF / 256, F.G, F.bid, (size_t)256 * D * 2, (size_t)256 * D * 2, ch * FCH); const float usc = 1.0f;
#endif
                  fill_rtab<true>(F, S, rtab, SSA);
#if F8_DDN
                  pg8::EpiSwiGLU E{HID8, 0, usc}; pg8::gemm_phase<pg8::EpiSwiGLU, pg8::StaticOrder, false, 1, F8_DUP != 0>(F.tid, F.lds, g, S, E, gtab, rtab); }
#else
                  pg8::EpiSwiGLU16 E{(bf16*)HID8, 0, usc}; pg8::gemm_phase<pg8::EpiSwiGLU16, pg8::StaticOrder, false, 1, F8_DUP != 0>(F.tid, F.lds, g, S, E, gtab, rtab); }
#endif
                xcd_barrier(bar, F.wave0); RELAUNDER();
#if F8_DDN
                PH(12) { pg8::Gemm g{(const bf16*)HID8, (const bf16*)(ws + WS_WDENSE + 14 * MiB), DFF / 2, DFF / 2, 128}; pg8::StaticOrder S; S.init(FCH, D / 256, F.G, F.bid, (size_t)256 * DFF, (size_t)256 * DFF, ch * FCH);
                  pg8::EpiRes16<(F8_GATE != 0)> E{P16, P16, SSB, H8, 1.0f / (S8_HID * S8_WD)}; pg8::gemm_phase<pg8::EpiRes16<(F8_GATE != 0)>, pg8::StaticOrder, false, 0, true>(F.tid, F.lds, g, S, E, gtab); }
#else
                PH(12) { pg8::Gemm g{(const bf16*)HID8, (const bf16*)(ws + WS_WDENSE + 14 * MiB), DFF, DFF, 128}; pg8::StaticOrder S; S.init(FCH, D / 256, F.G, F.bid, (size_t)256 * DFF * 2, (size_t)256 * DFF * 2, ch * FCH);
                  pg8::EpiRes16<false> E{P16, P16, SSB, nullptr, 1.0f}; pg8::gemm_phase<pg8::EpiRes16<false>, pg8::StaticOrder, false>(F.tid, F.lds, g, S, E, gtab); }
#endif
                RELAUNDER();
            }
        } else {
            PH(14) norm_router(F, Q16, args.in[I_GFFN] + (size_t)L * D, args.in[I_ROUTER], TOKINFO, BCNT);
            xcd_barrier(bar, F.wave0); RELAUNDER();
            PH(15) moe_index(F, BCNT, TOKINFO, TOKROW, ROWTOK, META);
            xcd_barrier(bar, F.wave0); RELAUNDER();
            const int NP = __builtin_amdgcn_readfirstlane(__hip_atomic_load(META, __ATOMIC_RELAXED, __HIP_MEMORY_SCOPE_AGENT));
            const int rp = (NP + MOE_ROUNDS - 1) / MOE_ROUNDS, nrounds = rp > 0 ? (NP + rp - 1) / rp : 0;
            for (int rd = 0; rd < nrounds; ++rd) {
                const int pm0 = rd * rp, npan = (NP - pm0) < rp ? (NP - pm0) : rp;
                PH(16) { pg8::StaticOrder S0; S0.init(npan, 2 * DFF / 256, F.G, F.bid, 0, 0); int n = 0; pg8::Unit u;
                  int nrs = 0, lastpm = -1;
                  for (int i = 0; i < 32 && S0.next(i, u); ++i) { const int pm = pm0 + u.pm; const int ex = META[16 + pm];
                      if (F.tid == 0) { uinfo[4 * i] = pm; uinfo[4 * i + 1] = u.pn; uinfo[4 * i + 2] = ex; }
                      if (pm != lastpm) { if (nrs < 15 && F.tid == 0) uinfo[4 * nrs + 3] = pm; lastpm = pm; ++nrs; }
                      n = i + 1; }
                  __syncthreads();
                  { const int ns = nrs < 15 ? nrs : 15, r = F.tid & 255, s0 = F.tid >> 8; int toks[8];
#pragma unroll
                    for (int j = 0; j < 8; ++j) { const int sl = s0 + 2 * j; toks[j] = (sl < ns) ? ROWTOK[uinfo[4 * sl + 3] * 256 + r] : 0; }
#pragma unroll
                    for (int j = 0; j < 8; ++j) { const int sl = s0 + 2 * j; if (sl < ns) { ((LAS int*)(F.lds + GTAB_OFF))[sl * 256 + r] = toks[j]; rtab[sl * 256 + r] = rstd_from_ss(SSA, toks[j]); } } }
                  __syncthreads();
#if F8_MOE
                  pg8::Gemm g{(const bf16*)H8, (const bf16*)(ws + WS_WMOE), D / 2, D / 2, 128}; pg8::MoeOrder S{uinfo, n, pm0, 0, (size_t)256 * D, WE_STRIDE};
                  pg8::EpiSwiGLU E{HID8, pm0 * 256, 1.0f / (S8_H * S8_WU)}; pg8::gemm_phase<pg8::EpiSwiGLU, pg8::MoeOrder, true, 1, true>(F.tid, F.lds, g, S, E, gtab, rtab); }
#else
                  pg8::Gemm g{Q16, (const bf16*)(ws + WS_WMOE), D, D, 128}; pg8::MoeOrder S{uinfo, n, pm0, 0, (size_t)256 * D * 2, WE_STRIDE};
                  pg8::EpiSwiGLU16 E{(bf16*)HID8, pm0 * 256}; pg8::gemm_phase<pg8::EpiSwiGLU16, pg8::MoeOrder, true, 1>(F.tid, F.lds, g, S, E, gtab, rtab); }
#endif
                xcd_barrier(bar, F.wave0); RELAUNDER();
                PH(17) { pg8::StaticOrder S0; S0.init(npan, D / 256, F.G, F.bid, 0, 0); int n = 0; pg8::Unit u;
                  for (int i = 0; i < 32 && S0.next(i, u); ++i) { const int pm = pm0 + u.pm; const int ex = META[16 + pm];
                      if (F.tid == 0) { uinfo[4 * i] = pm; uinfo[4 * i + 1] = u.pn; uinfo[4 * i + 2] = ex; } n = i + 1; }
                  __syncthreads();
#if F8_MOE
                  pg8::Gemm g{(const bf16*)HID8, (const bf16*)(ws + WS_WMOE + WE_DOWN), DFF / 2, DFF / 2, 128}; pg8::MoeOrder S{uinfo, n, pm0, (size_t)256 * DFF, (size_t)256 * DFF, WE_STRIDE};
                  pg8::EpiOut8 E{YP8, D, S8_Y / (S8_HID * S8_WD)}; pg8::gemm_phase<pg8::EpiOut8, pg8::MoeOrder, false, 0, true>(F.tid, F.lds, g, S, E, gtab); }
#else
                  pg8::Gemm g{(const bf16*)HID8, (const bf16*)(ws + WS_WMOE + WE_DOWN), DFF, DFF, 128}; pg8::MoeOrder S{uinfo, n, pm0, (size_t)256 * DFF * 2, (size_t)256 * DFF * 2, WE_STRIDE};
                  pg8::EpiBf16<0> E{YP, D, nullptr, 0}; pg8::gemm_phase<pg8::EpiBf16<0>, pg8::MoeOrder, false>(F.tid, F.lds, g, S, E, gtab); }
#endif
                xcd_barrier(bar, F.wave0); RELAUNDER();
            }
            PH(18) moe_combine(F, Q16, H8, RSTD, YP8, TOKROW, TOKINFO);
        }
        xcd_barrier(bar, F.wave0); RELAUNDER();
        PH(20) {
#if F8_GATE
          pg8::Gemm g{(const bf16*)H8, (const bf16*)(wl + WL_PGATE), D / 2, D / 2, 128}; pg8::StaticOrder S; S.init(T / 256, D / 256, F.G, F.bid, (size_t)256 * D, (size_t)256 * D);
          if (L == 0) fill_rtab<true>(F, S, rtab, SSB); else fill_rtab<false>(F, S, rtab, RSTD);
          pg8::EpiSig8 E{SIG8, 1.0f / (S8_H * S8_WU)}; pg8::gemm_phase<pg8::EpiSig8, pg8::StaticOrder, false, 1, true>(F.tid, F.lds, g, S, E, gtab, rtab); }
#else
          pg8::Gemm g{HL, (const bf16*)(wl + WL_PGATE), D, D, 128}; pg8::StaticOrder S; S.init(T / 256, D / 256, F.G, F.bid, (size_t)256 * D * 2, (size_t)256 * D * 2);
          if (L == 0) fill_rtab<true>(F, S, rtab, SSB); else fill_rtab<false>(F, S, rtab, RSTD);
          pg8::EpiSig8 E{SIG8}; pg8::gemm_phase<pg8::EpiSig8, pg8::StaticOrder, false, 1>(F.tid, F.lds, g, S, E, gtab, rtab); }
#endif
        __syncthreads();
        PH(19) { pg8::Gemm g{PBALL + (size_t)L * T * PLE, (const bf16*)(wl + WL_PPROJ), PLE, PLE, 128}; pg8::StaticOrder S; S.init(T / 256, D / 256, F.G, F.bid, (size_t)256 * PLE * 2, (size_t)256 * PLE * 2);
          if (L == 0) { pg8::EpiPleApply<true> E{P16, SIG8, Q16, SSA, ws + WS_AR};     pg8::gemm_phase<pg8::EpiPleApply<true>, pg8::StaticOrder, false>(F.tid, F.lds, g, S, E, gtab); }
          else { pg8::EpiPleApply<false> E{Q16, SIG8, H16C, nullptr}; pg8::gemm_phase<pg8::EpiPleApply<false>, pg8::StaticOrder, false>(F.tid, F.lds, g, S, E, gtab); } }
        xcd_barrier(bar, F.wave0); RELAUNDER();
    }
    PH(22) norm_final(F, H16C, args.in[I_GFINAL], args.out);
}

extern "C" void kernel_launch(void* const* d_in, const int* in_sizes, int n_in, void* d_out, int out_size, void* d_ws, size_t ws_size, hipStream_t stream) {
    static int grid = 0;
    if (grid == 0) {
        if (n_in != 21 || out_size != T * D || ws_size < WS_END) { fprintf(stderr, "kernel_launch: unexpected shapes (n_in %d out %d ws %zu)\n", n_in, out_size, ws_size); grid = -1; return; }
        int dev = 0, cus = 0, per_cu = 0;
        if (hipGetDevice(&dev) != hipSuccess || hipDeviceGetAttribute(&cus, hipDeviceAttributeMultiprocessorCount, dev) != hipSuccess) { grid = -1; return; }
        if (hipFuncSetAttribute((const void*)hybrid_fwd, hipFuncAttributeMaxDynamicSharedMemorySize, LDS_BYTES) != hipSuccess) { fprintf(stderr, "kernel_launch: hipFuncSetAttribute failed\n"); grid = -1; return; }
        if (hipOccupancyMaxActiveBlocksPerMultiprocessor(&per_cu, (const void*)hybrid_fwd, NTHR, LDS_BYTES) != hipSuccess || per_cu < 1) fprintf(stderr, "kernel_launch: occupancy query reports %d\n", per_cu);
        (void)hipGetLastError();
        grid = cus;
    }
    if (grid < 0) return;
    if (hipMemsetAsync((char*)d_ws + WS_CTL, 0, CTL_ZERO_BYTES, stream) != hipSuccess) return;
    Args a{};
    for (int i = 0; i < 21; ++i) a.in[i] = (const float*)d_in[i];
    a.out = (float*)d_out; a.ws = (unsigned char*)d_ws;
    hipLaunchKernelGGL(hybrid_fwd, dim3(grid), dim3(NTHR), LDS_BYTES, stream, a);
}
```
